# Optimizing an MI355X kernel written in HIP

```python
import math
import jax, jax.numpy as jnp
from jax import lax
import numpy as np

D_MODEL = 1024
BATCH = 2
SEQ = 8192
DEPTH = 4

D_FF = ((8 * D_MODEL // 3 + 255) // 256) * 256
S5_WIDTH = D_MODEL // 4
S5_GROUP_DIM = 16
S5_GROUPS = S5_WIDTH // S5_GROUP_DIM
S5_STATE = 64
RET_WIDTH = D_MODEL // 2
RET_HEAD_DIM = 128
RET_HEADS = RET_WIDTH // RET_HEAD_DIM
RET_CHUNK = 128
LRU_WIDTH = D_MODEL - S5_WIDTH - RET_WIDTH
LRU_BLOCKS = 4
LRU_BLOCK_DIM = LRU_WIDTH // LRU_BLOCKS
CONV_WIDTH = 4
LRU_C = 8.0
ROPE_BASE = 10000.0
NORM_EPS = 1e-6
IN_SECTIONS = (S5_WIDTH, RET_WIDTH, RET_WIDTH, RET_WIDTH, RET_WIDTH, LRU_WIDTH, LRU_WIDTH)
IN_WIDTH = sum(IN_SECTIONS)

kernel_name = 'hymba_s5_retnet_rglru_macaron'


def rmsnorm(x, g):
    xf = x.astype(jnp.float32)
    xf = xf * lax.rsqrt(jnp.mean(xf * xf, axis=-1, keepdims=True) + NORM_EPS)
    return xf.astype(x.dtype) * g


def swiglu(x, w_gate, w_up, w_down):
    return (jax.nn.silu(x @ w_gate) * (x @ w_up)) @ w_down


def s5_mixer(u, lam_re, lam_im, log_step, b_re, b_im, c_re, c_im, d_skip, w_glu, b_glu):
    B, S, W = u.shape
    ug = u.reshape(B, S, S5_GROUPS, S5_GROUP_DIM)
    step = jnp.exp(log_step)[:, None]
    ar = lam_re * step
    ai = lam_im * step
    mag = jnp.exp(ar)
    lb_re = mag * jnp.cos(ai)
    lb_im = mag * jnp.sin(ai)
    nr = lb_re - 1.0
    den = lam_re * lam_re + lam_im * lam_im
    fr = (nr * lam_re + lb_im * lam_im) / den
    fi = (lb_im * lam_re - nr * lam_im) / den
    bb_re = fr[..., None] * b_re - fi[..., None] * b_im
    bb_im = fr[..., None] * b_im + fi[..., None] * b_re
    bu_re = jnp.einsum('bsgh,gph->bsgp', ug, bb_re)
    bu_im = jnp.einsum('bsgh,gph->bsgp', ug, bb_im)
    a_re = jnp.broadcast_to(lb_re, bu_re.shape)
    a_im = jnp.broadcast_to(lb_im, bu_im.shape)

    def combine(e1, e2):
        a1r, a1i, b1r, b1i = e1
        a2r, a2i, b2r, b2i = e2
        return (a2r * a1r - a2i * a1i,
                a2r * a1i + a2i * a1r,
                a2r * b1r - a2i * b1i + b2r,
                a2r * b1i + a2i * b1r + b2i)

    _, _, s_re, s_im = lax.associative_scan(combine, (a_re, a_im, bu_re, bu_im), axis=1)
    y = jnp.einsum('bsgp,ghp->bsgh', s_re, c_re) - jnp.einsum('bsgp,ghp->bsgh', s_im, c_im)
    y = y.reshape(B, S, W) + d_skip * u
    y = jax.nn.gelu(y)
    return y * jax.nn.sigmoid(y @ w_glu + b_glu)


def retention(q, k, v, g):
    B, S, _ = q.shape
    H, Dh, C = RET_HEADS, RET_HEAD_DIM, RET_CHUNK
    N = S // C
    dt = q.dtype
    pos = jnp.arange(S, dtype=jnp.float32)
    inv_freq = ROPE_BASE ** (-jnp.arange(0, Dh, 2, dtype=jnp.float32) / Dh)
    ang = pos[:, None] * inv_freq[None, :]
    cos = jnp.cos(ang).astype(dt)[None, :, None, :]
    sin = jnp.sin(ang).astype(dt)[None, :, None, :]

    def rope(t):
        t = t.reshape(B, S, H, Dh)
        t1, t2 = t[..., :Dh // 2], t[..., Dh // 2:]
        return jnp.concatenate([t1 * cos - t2 * sin, t1 * sin + t2 * cos], axis=-1)

    def chunks(t):
        return t.reshape(B, N, C, H, Dh).transpose(0, 3, 1, 2, 4)

    qc = chunks(rope(q) * (Dh ** -0.5))
    kc = chunks(rope(k))
    vc = chunks(v.reshape(B, S, H, Dh))

    log_gamma = jnp.log1p(-jnp.exp2(-5.0 - jnp.arange(H, dtype=jnp.float32)))
    idx = jnp.arange(C, dtype=jnp.float32)
    diff = idx[:, None] - idx[None, :]
    decay = jnp.where(diff[None] >= 0,
                      jnp.exp(jnp.maximum(diff, 0.0)[None] * log_gamma[:, None, None]),
                      0.0).astype(dt)
    zeta = jnp.exp((C - 1.0 - idx)[None] * log_gamma[:, None]).astype(dt)
    xi = jnp.exp((idx + 1.0)[None] * log_gamma[:, None]).astype(dt)
    gamma_chunk = jnp.exp(C * log_gamma).astype(dt)

    scores = jnp.einsum('bhncd,bhnmd->bhncm', qc, kc) * decay[None, :, None]
    inner = jnp.einsum('bhncm,bhnme->bhnce', scores, vc)
    kv = jnp.einsum('bhnmd,bhnme->bhnde', kc * zeta[None, :, None, :, None], vc)

    def step(state, kv_n):
        return gamma_chunk[None, :, None, None] * state + kv_n, state

    _, prev = lax.scan(step, jnp.zeros((B, H, Dh, Dh), dt), jnp.moveaxis(kv, 2, 0))
    prev = jnp.moveaxis(prev, 0, 2)
    cross = jnp.einsum('bhncd,bhnde->bhnce', qc, prev) * xi[None, :, None, :, None]
    o = (inner + cross).transpose(0, 2, 3, 1, 4).reshape(B, S, H, Dh)
    of = o.astype(jnp.float32)
    of = of * lax.rsqrt(jnp.mean(of * of, axis=-1, keepdims=True) + NORM_EPS)
    o = of.astype(dt).reshape(B, S, H * Dh)
    return jax.nn.silu(g) * o


def rglru_branch(xb, gate_b, conv_w, conv_b, w_a, b_a, w_x, b_x, lam):
    B, S, W = xb.shape
    xc = lax.conv_general_dilated(xb, conv_w.reshape(CONV_WIDTH, 1, W), window_strides=(1,),
                                  padding=[(CONV_WIDTH - 1, 0)],
                                  dimension_numbers=('NWC', 'WIO', 'NWC'),
                                  feature_group_count=W) + conv_b
    xblk = xc.reshape(B, S, LRU_BLOCKS, LRU_BLOCK_DIM)
    r = jax.nn.sigmoid(jnp.einsum('bsnd,nde->bsne', xblk, w_a) + b_a.reshape(LRU_BLOCKS, LRU_BLOCK_DIM)).reshape(B, S, W)
    i = jax.nn.sigmoid(jnp.einsum('bsnd,nde->bsne', xblk, w_x) + b_x.reshape(LRU_BLOCKS, LRU_BLOCK_DIM)).reshape(B, S, W)
    log_a = -LRU_C * r * jax.nn.softplus(-lam)
    a = jnp.exp(log_a)
    mult = jnp.sqrt(-jnp.expm1(2.0 * log_a))
    bterm = mult * (i * xc)

    def combine(e1, e2):
        a1, b1 = e1
        a2, b2 = e2
        return a2 * a1, a2 * b1 + b2

    _, h = lax.associative_scan(combine, (a, bterm), axis=1)
    return h * jax.nn.gelu(gate_b)


def setup_inputs(seed: int = 0) -> dict:
    key = jax.random.key(seed)
    ks = iter(jax.random.split(key, 48))
    L, D, F = DEPTH, D_MODEL, D_FF
    G, P, Hg = S5_GROUPS, S5_STATE, S5_GROUP_DIM
    f32 = jnp.float32

    def nrm(shape, scale):
        return jax.random.normal(next(ks), shape, f32) * scale

    def gain(shape):
        return 1.0 + 0.01 * jax.random.normal(next(ks), shape, f32)

    u_lru = jax.random.uniform(next(ks), (L, LRU_WIDTH), f32, 0.9, 0.999)
    a0 = u_lru ** (1.0 / LRU_C)
    return {
        'x': jax.random.normal(next(ks), (BATCH, SEQ, D), f32),
        'ffn1_norm': gain((L, D)),
        'ffn1_w_gate': nrm((L, D, F), D ** -0.5),
        'ffn1_w_up': nrm((L, D, F), D ** -0.5),
        'ffn1_w_down': nrm((L, F, D), F ** -0.5),
        'mix_norm': gain((L, D)),
        'w_in': nrm((L, D, IN_WIDTH), D ** -0.5),
        's5_lambda_re': -0.5 + 0.01 * jax.random.normal(next(ks), (L, G, P), f32),
        's5_lambda_im': jnp.pi * jnp.arange(P, dtype=f32)[None, None, :] + 0.01 * jax.random.normal(next(ks), (L, G, P), f32),
        's5_log_step': jax.random.uniform(next(ks), (L, G), f32, math.log(1e-3), math.log(1e-1)),
        's5_b_re': nrm((L, G, P, Hg), (2.0 * Hg) ** -0.5),
        's5_b_im': nrm((L, G, P, Hg), (2.0 * Hg) ** -0.5),
        's5_c_re': nrm((L, G, Hg, P), P ** -0.5),
        's5_c_im': nrm((L, G, Hg, P), P ** -0.5),
        's5_d': nrm((L, S5_WIDTH), 1.0),
        's5_w_glu': nrm((L, S5_WIDTH, S5_WIDTH), S5_WIDTH ** -0.5),
        's5_b_glu': nrm((L, S5_WIDTH), 0.01),
        's5_out_norm': gain((L, S5_WIDTH)),
        'ret_out_norm': gain((L, RET_WIDTH)),
        'lru_conv_w': nrm((L, CONV_WIDTH, LRU_WIDTH), CONV_WIDTH ** -0.5),
        'lru_conv_b': nrm((L, LRU_WIDTH), 0.01),
        'lru_w_a': nrm((L, LRU_BLOCKS, LRU_BLOCK_DIM, LRU_BLOCK_DIM), LRU_BLOCK_DIM ** -0.5),
        'lru_b_a': nrm((L, LRU_WIDTH), 0.01),
        'lru_w_x': nrm((L, LRU_BLOCKS, LRU_BLOCK_DIM, LRU_BLOCK_DIM), LRU_BLOCK_DIM ** -0.5),
        'lru_b_x': nrm((L, LRU_WIDTH), 0.01),
        'lru_lambda': jnp.log(a0) - jnp.log1p(-a0),
        'lru_out_norm': gain((L, LRU_WIDTH)),
        'w_out': nrm((L, D, D), D ** -0.5),
        'ffn2_norm': gain((L, D)),
        'ffn2_w_gate': nrm((L, D, F), D ** -0.5),
        'ffn2_w_up': nrm((L, D, F), D ** -0.5),
        'ffn2_w_down': nrm((L, F, D), F ** -0.5),
        'final_norm': gain((D,)),
    }


def reference(x, ffn1_norm, ffn1_w_gate, ffn1_w_up, ffn1_w_down, mix_norm, w_in,
              s5_lambda_re, s5_lambda_im, s5_log_step, s5_b_re, s5_b_im, s5_c_re, s5_c_im,
              s5_d, s5_w_glu, s5_b_glu, s5_out_norm, ret_out_norm,
              lru_conv_w, lru_conv_b, lru_w_a, lru_b_a, lru_w_x, lru_b_x, lru_lambda, lru_out_norm,
              w_out, ffn2_norm, ffn2_w_gate, ffn2_w_up, ffn2_w_down, final_norm):
    split_pts = [int(p) for p in np.cumsum(IN_SECTIONS)[:-1]]
    for l in range(DEPTH):
        h = rmsnorm(x, ffn1_norm[l])
        x = x + 0.5 * swiglu(h, ffn1_w_gate[l], ffn1_w_up[l], ffn1_w_down[l])
        h = rmsnorm(x, mix_norm[l])
        z = h @ w_in[l]
        u_s5, q, k, v, g, x_lru, g_lru = jnp.split(z, split_pts, axis=-1)
        y_s5 = s5_mixer(u_s5, s5_lambda_re[l], s5_lambda_im[l], s5_log_step[l], s5_b_re[l], s5_b_im[l],
                        s5_c_re[l], s5_c_im[l], s5_d[l], s5_w_glu[l], s5_b_glu[l])
        y_ret = retention(q, k, v, g)
        y_lru = rglru_branch(x_lru, g_lru, lru_conv_w[l], lru_conv_b[l], lru_w_a[l], lru_b_a[l],
                             lru_w_x[l], lru_b_x[l], lru_lambda[l])
        y = jnp.concatenate([rmsnorm(y_s5, s5_out_norm[l]),
                             rmsnorm(y_ret, ret_out_norm[l]),
                             rmsnorm(y_lru, lru_out_norm[l])], axis=-1)
        x = x + y @ w_out[l]
        h = rmsnorm(x, ffn2_norm[l])
        x = x + 0.5 * swiglu(h, ffn2_w_gate[l], ffn2_w_up[l], ffn2_w_down[l])
    return rmsnorm(x, final_norm)
```

```cpp
#include <hip/hip_runtime.h>
#include <hip/hip_cooperative_groups.h>
#include <cstdio>
#include <cstdint>
namespace cg = cooperative_groups;
namespace pg8 {
#define PG8_LAS __attribute__((address_space(3)))
typedef unsigned short bf16_t;
typedef short bf16x8 __attribute__((ext_vector_type(8)));
typedef float f32x4 __attribute__((ext_vector_type(4)));
typedef unsigned u32x4 __attribute__((ext_vector_type(4)));
constexpr int BM = 256, BK = 64, HALF = 128, HTB = HALF * BK * 2  , STAGE_BYTES = 8 * HTB, NXCD = 8, WGM = 2;

__host__ __device__ __forceinline__ int lds_byte(int r, int c) { const int st = (r >> 4) * 2 + (c >> 5), rr = r & 15, cc = c & 31, ob = rr * 64 + cc * 2; return st * 1024 + (ob ^ (((ob >> 9) & 1) << 5)); }
__host__ __device__ __forceinline__ void stage_rc(int b, int& R, int& C) { const int st = b / 1024, sb = b % 1024, swz = sb ^ (((sb >> 9) & 1) << 5); R = (st >> 1) * 16 + swz / 64; C = (st & 1) * 32 + (swz % 64) / 2; }
__host__ __device__ __forceinline__ int perm32(int rho) { const int n = rho >> 4, i = rho & 15; return 8 * (i >> 2) + 4 * n + (i & 3); }

struct Unit { int pm, pn; };
struct Gemm { const bf16_t* A; const bf16_t* Bt; int M, N, K; };

struct StaticOrder {
    int nM, nN, nwg, G, c;
    __host__ __device__ void init(int M, int N, int G_, int c_) { nM = M / BM; nN = N / BM; nwg = nM * nN; G = G_; c = c_; }
    __host__ __device__ bool next(int i, Unit& u) const {
        const long L = (long)i * G + c; if (L >= nwg) return false;
        int wgid = (int)L; { const int q = nwg / NXCD, r = nwg % NXCD, xcd = wgid % NXCD, off = wgid / NXCD; wgid = (xcd < r ? xcd * (q + 1) : r * (q + 1) + (xcd - r) * q) + off; }
        const int nig = WGM * nN, gid = wgid / nig, fm = gid * WGM, gsz = (nM - fm) < WGM ? (nM - fm) : WGM;
        u.pm = fm + ((wgid % nig) % gsz); u.pn = (wgid % nig) / gsz; return true;
    }
    __device__ __forceinline__ void a_ready(const Unit&) const {}
    __device__ __forceinline__ void done(const Unit&) const {}
};

__device__ __forceinline__ unsigned cvt_pk_bf16(float lo, float hi) { unsigned r; asm volatile("v_cvt_pk_bf16_f32 %0, %1, %2" : "=v"(r) : "v"(lo), "v"(hi)); return r; }
template <class Epi, class Sched, bool ALIGN_EPI = false, bool SP2 = false>
__device__ __forceinline__ void gemm_phase(PG8_LAS unsigned char* lds, const Gemm g, const Sched& S, const Epi& E) {
    int tid_ = threadIdx.x; asm volatile("" : "+v"(tid_)); const int tid = tid_, wid = __builtin_amdgcn_readfirstlane(tid >> 6), lane = tid & 63, wr = wid >> 2, wc = wid & 3, fr = lane & 15, fq = lane >> 4;
    const int K = g.K, nt = K / BK;
    unsigned voffA[2], voffB[2];
#pragma unroll
    for (int i = 0; i < 2; ++i) { int R, C; stage_rc(tid * 16 + i * 8192, R, C); const int Rb = Epi::PERM ? ((R & ~31) + perm32(R & 31)) : R;
        voffA[i] = (unsigned)(R * K + C) * 2u; voffB[i] = (unsigned)(Rb * K + C) * 2u; }
    const size_t kstep = (size_t)(BK * 2);
    const size_t hstep = (size_t)HALF * K * 2;
    const size_t tstep = 2 * hstep;
    const unsigned ldsw = (unsigned)wid * 1024u;
    const int aoff = lds_byte(wr * 64 + fr, fq * 8), boff = lds_byte(wc * 32 + fr, fq * 8);
#define PG8_SA(b, h) (((b) * 2 + (h)) * HTB)
#define PG8_SB(b, h) ((4 + (b) * 2 + (h)) * HTB)
#define PG8_STAGE(bufoff, gbase, voff) do { _Pragma("unroll") for (int _i = 0; _i < 2; ++_i) \
        __builtin_amdgcn_global_load_lds((const unsigned*)((const char*)(gbase) + (voff)[_i]), (PG8_LAS unsigned*)(lds + (bufoff) + ldsw + _i * 8192), 16, 0, 0); } while (0)
#define PG8_LDA(dst, b, h) do { _Pragma("unroll") for (int m = 0; m < 4; ++m) _Pragma("unroll") for (int k = 0; k < 2; ++k) dst[m][k] = *(const PG8_LAS bf16x8*)(lds + PG8_SA(b, h) + aoff + m * 2048 + k * 1024); } while (0)
#define PG8_LDB(dst, b, h) do { _Pragma("unroll") for (int n = 0; n < 2; ++n) _Pragma("unroll") for (int k = 0; k < 2; ++k) dst[n][k] = *(const PG8_LAS bf16x8*)(lds + PG8_SB(b, h) + boff + n * 2048 + k * 1024); } while (0)
#define PG8_MMA(ai, bj, At, Bt) do { __builtin_amdgcn_s_setprio(1); _Pragma("unroll") for (int m = 0; m < 4; ++m) _Pragma("unroll") for (int n = 0; n < 2; ++n) _Pragma("unroll") for (int k = 0; k < 2; ++k) \
        acc[ai][bj][m][n] = __builtin_amdgcn_mfma_f32_16x16x32_bf16(Bt[n][k], At[m][k], acc[ai][bj][m][n], 0, 0, 0); __builtin_amdgcn_s_setprio(0); } while (0)
#define PG8_WAIT_V(n) asm volatile("s_waitcnt vmcnt(" #n ")" ::: "memory")
#define PG8_WAIT_L(n) asm volatile("s_waitcnt lgkmcnt(" #n ")" ::: "memory")
#define PG8_BAR __builtin_amdgcn_s_barrier()
#define PG8_SCHED __builtin_amdgcn_sched_barrier(0)
    Unit cur, nxt; int ui = 0;
    if (!S.next(0, cur)) return;
    f32x4 acc[2][2][4][2];
    typename Epi::Pre pre0 = E.issue(cur, wr, wc, fr, fq);
    bf16x8 At[4][2], B0[2][2], B1[2][2];
    const char* cA = (const char*)g.A + (size_t)cur.pm * tstep; const char* cB = (const char*)g.Bt + (size_t)cur.pn * tstep;
    S.a_ready(cur);
    if constexpr (SP2) {
        PG8_STAGE(PG8_SB(0, 0), cB, voffB); PG8_STAGE(PG8_SB(0, 1), cB + hstep, voffB); PG8_STAGE(PG8_SA(0, 0), cA, voffA); PG8_STAGE(PG8_SA(0, 1), cA + hstep, voffA);
        if (wr == 1) PG8_BAR;
        PG8_WAIT_V(2); PG8_BAR;
        PG8_STAGE(PG8_SB(1, 0), cB + kstep, voffB); PG8_STAGE(PG8_SA(1, 0), cA + kstep, voffA); PG8_STAGE(PG8_SB(1, 1), cB + hstep + kstep, voffB);
        PG8_WAIT_V(6); PG8_BAR;
    } else {
        PG8_STAGE(PG8_SB(0, 0), cB, voffB); PG8_STAGE(PG8_SA(0, 0), cA, voffA); PG8_STAGE(PG8_SB(0, 1), cB + hstep, voffB); PG8_STAGE(PG8_SA(0, 1), cA + hstep, voffA);
        if (wr == 1) PG8_BAR;
        PG8_WAIT_V(4); PG8_BAR;
        PG8_STAGE(PG8_SB(1, 0), cB + kstep, voffB); PG8_STAGE(PG8_SA(1, 0), cA + kstep, voffA); PG8_STAGE(PG8_SB(1, 1), cB + hstep + kstep, voffB);
        PG8_WAIT_V(6); PG8_BAR;
    }
    PG8_SCHED; E.finish(acc, pre0); PG8_SCHED;
    for (;;) {
        const bool has_next = S.next(ui + 1, nxt);
        const char* nA = has_next ? (const char*)g.A + (size_t)nxt.pm * tstep : cA; const char* nB = has_next ? (const char*)g.Bt + (size_t)nxt.pn * tstep : cB;
        for (int t = 0; t < nt; t += 2) {
            const bool last = (t == nt - 2);
            const char* a1 = cA + (size_t)(t + 1) * kstep;
            const char* a2 = last ? nA : cA + (size_t)(t + 2) * kstep; const char* b2 = last ? nB : cB + (size_t)(t + 2) * kstep;
            const char* a3 = a2 + kstep; const char* b3 = b2 + kstep;
            if (last && has_next) S.a_ready(nxt);
            if (last) E.pre(cur, wid, lane);
            if constexpr (SP2) {
            PG8_LDB(B0, 0, 0); PG8_LDB(B1, 0, 1); PG8_SCHED; PG8_LDA(At, 0, 0); PG8_STAGE(PG8_SA(1, 1), a1 + hstep, voffA);
            PG8_WAIT_V(8); PG8_WAIT_L(0); PG8_BAR; PG8_MMA(0, 0, At, B0); PG8_MMA(0, 1, At, B1); PG8_BAR; PG8_SCHED;
            PG8_LDA(At, 0, 1); PG8_STAGE(PG8_SB(0, 0), b2, voffB); PG8_STAGE(PG8_SB(0, 1), b2 + hstep, voffB); PG8_STAGE(PG8_SA(0, 0), a2, voffA);
            PG8_WAIT_V(8); PG8_WAIT_L(0); PG8_BAR; PG8_MMA(1, 0, At, B0); PG8_MMA(1, 1, At, B1); PG8_BAR; PG8_SCHED;
            PG8_LDB(B0, 1, 0); PG8_LDB(B1, 1, 1); PG8_SCHED; PG8_LDA(At, 1, 0); PG8_STAGE(PG8_SA(0, 1), a2 + hstep, voffA);
            PG8_WAIT_V(8); PG8_WAIT_L(0); PG8_BAR; PG8_MMA(0, 0, At, B0); PG8_MMA(0, 1, At, B1); PG8_BAR; PG8_SCHED;
            PG8_LDA(At, 1, 1); PG8_STAGE(PG8_SB(1, 0), b3, voffB); PG8_STAGE(PG8_SB(1, 1), b3 + hstep, voffB); PG8_STAGE(PG8_SA(1, 0), a3, voffA);
            PG8_WAIT_V(8); PG8_WAIT_L(0); PG8_BAR; PG8_MMA(1, 0, At, B0); PG8_MMA(1, 1, At, B1); PG8_BAR; PG8_SCHED;
            } else {
            PG8_LDB(B0, 0, 0); PG8_SCHED; PG8_LDA(At, 0, 0); PG8_STAGE(PG8_SA(1, 1), a1 + hstep, voffA);
            PG8_WAIT_L(8); PG8_BAR; PG8_WAIT_L(0); PG8_MMA(0, 0, At, B0); PG8_BAR; PG8_SCHED;
            PG8_LDB(B1, 0, 1); PG8_STAGE(PG8_SB(0, 0), b2, voffB);
            PG8_BAR; PG8_WAIT_L(0); PG8_MMA(0, 1, At, B1); PG8_BAR;
            PG8_LDA(At, 0, 1); PG8_STAGE(PG8_SA(0, 0), a2, voffA);
            PG8_BAR; PG8_WAIT_L(0); PG8_MMA(1, 0, At, B0); PG8_BAR; PG8_SCHED;
            PG8_STAGE(PG8_SB(0, 1), b2 + hstep, voffB);
            PG8_WAIT_V(6); PG8_BAR; PG8_MMA(1, 1, At, B1); PG8_BAR;
            PG8_LDB(B0, 1, 0); PG8_SCHED; PG8_LDA(At, 1, 0); PG8_STAGE(PG8_SA(0, 1), a2 + hstep, voffA);
            PG8_WAIT_L(8); PG8_BAR; PG8_WAIT_L(0); PG8_MMA(0, 0, At, B0); PG8_BAR; PG8_SCHED;
            PG8_LDB(B1, 1, 1); PG8_STAGE(PG8_SB(1, 0), b3, voffB);
            PG8_BAR; PG8_WAIT_L(0); PG8_MMA(0, 1, At, B1); PG8_BAR;
            PG8_LDA(At, 1, 1); PG8_STAGE(PG8_SA(1, 0), a3, voffA);
            PG8_BAR; PG8_WAIT_L(0); PG8_MMA(1, 0, At, B0); PG8_BAR; PG8_SCHED;
            PG8_STAGE(PG8_SB(1, 1), b3 + hstep, voffB);
            PG8_WAIT_V(6); PG8_BAR; PG8_MMA(1, 1, At, B1); PG8_BAR;
            }
        }
        if constexpr (ALIGN_EPI) { if (wr == 0) PG8_BAR; }
        if constexpr (!Epi::AFTER_DRAIN) { E(acc, cur, wr, wc, fr, fq); S.done(cur); }
        if (!has_next) break;
        { typename Epi::Pre pren = E.issue(nxt, wr, wc, fr, fq); E.finish(acc, pren); }
        cur = nxt; cA = nA; cB = nB; ++ui;
        if constexpr (ALIGN_EPI) { if (wr == 1) PG8_BAR; }
    }
    PG8_WAIT_V(0);
    if constexpr (!ALIGN_EPI) { if (wr == 0) PG8_BAR; }
    PG8_BAR;
    if constexpr (Epi::AFTER_DRAIN) { E.fused(acc, cur, wr, wc, fr, fq, lds, wid, lane); S.done(cur); }
#undef PG8_SA
#undef PG8_SB
#undef PG8_STAGE
#undef PG8_LDA
#undef PG8_LDB
#undef PG8_MMA
#undef PG8_WAIT_V
#undef PG8_WAIT_L
#undef PG8_BAR
#undef PG8_SCHED
}
}

#define LAS __attribute__((address_space(3)))
typedef unsigned short bf16;
typedef float f32x4 __attribute__((ext_vector_type(4)));
typedef float f32x2 __attribute__((ext_vector_type(2)));
typedef short bf16x8 __attribute__((ext_vector_type(8)));
typedef unsigned u32x4 __attribute__((ext_vector_type(4)));
typedef unsigned u32x2 __attribute__((ext_vector_type(2)));

constexpr int NTOK = 16384, SEQ = 8192, DM = 1024, FF = 2816, IW = 2816, NL = 4;
constexpr float EPS = 1e-6f;
constexpr int NTHR = 512, NWAVE = 8;
constexpr int LDS_BYTES = 155648;
constexpr int OFF_SSQL = 131072;

constexpr size_t MiB = 1u << 20;
constexpr size_t WS_CTL = 0;
constexpr size_t WS_ROPE = 1 * MiB;
constexpr size_t WS_SSQ = 5 * MiB;
constexpr size_t WS_S5E = 6 * MiB;
constexpr size_t WS_LRUC = 8 * MiB;
constexpr size_t WS_TAB = 9 * MiB;
constexpr size_t WS_W = 10 * MiB;
constexpr size_t WL_STRIDE = 43 * MiB;
constexpr size_t WL_GU1 = 0, WL_D1 = 11534336, WL_WIN = WL_D1 + 5767168, WL_WOUT = WL_WIN + 5767168, WL_GU2 = WL_WOUT + 2097152,
                 WL_D2 = WL_GU2 + 11534336, WL_GLU = WL_D2 + 5767168, WL_WA = WL_GLU + 131072, WL_WX = WL_WA + 32768, WL_CM = WL_WX + 32768,
                 WL_S5T = WL_CM + 65536, WL_BB = WL_S5T + 147456, WL_END = WL_BB + 65536;
static_assert(WL_END <= WL_STRIDE, "weights per layer");
constexpr size_t WS_XB = 182 * MiB;
constexpr size_t WS_HZ = 214 * MiB;
constexpr size_t WS_Y = 302 * MiB;
constexpr size_t WS_KV = 334 * MiB;
constexpr size_t WS_PB = 366 * MiB;
constexpr size_t WS_END = 382 * MiB;

struct Args { const float* in[33]; float* out; unsigned char* ws; };

#define XB_TMO      128
#define XB_XCNT(j)  (256  + 64 * (j))
#define XB_XSUB(j)  (1280 + 64 * (j))
#define XB_XGEN(j)  (2304 + 64 * (j))
#define XB_TOP      3328
#define XB_TOPGEN   3392
#define XCD_BAR_WORDS 3456
#define XB_SPIN_CAP (1u << 18)

__device__ __forceinline__ unsigned xb_ld(unsigned* p)              { return __hip_atomic_load(p, __ATOMIC_RELAXED, __HIP_MEMORY_SCOPE_AGENT); }
__device__ __forceinline__ unsigned xb_add(unsigned* p, unsigned v) { return __hip_atomic_fetch_add(p, v, __ATOMIC_RELAXED, __HIP_MEMORY_SCOPE_AGENT); }
__device__ __forceinline__ unsigned xb_xcc_id() { return (unsigned)__builtin_amdgcn_s_getreg((3 << 11) | 20) & 0xFu; }
#define XB_SPIN(cond, bar) do { unsigned _sp = 0; while (cond) { __builtin_amdgcn_s_sleep(1); \
    if ((++_sp & 255u) == 0u) { if (xb_ld(&(bar)[XB_TMO])) break; if (_sp > XB_SPIN_CAP) { atomicAdd(&(bar)[XB_TMO], 1u); break; } } } } while (0)

struct XcdBarrier {
    unsigned* bar; unsigned x;
    volatile LAS unsigned* st;
};

__device__ __forceinline__ XcdBarrier xcd_barrier_post(unsigned* bar, volatile LAS unsigned* st) {
    XcdBarrier b; b.bar = bar; b.x = xb_xcc_id(); b.st = st;
    if (threadIdx.x == 0) (void)xb_add(&bar[XB_XCNT(b.x)], 1u);
    return b;
}
__device__ __forceinline__ void xcd_barrier_complete(unsigned* bar, unsigned x, unsigned& nloc, unsigned& nx) {
    const unsigned G = gridDim.x * gridDim.y * gridDim.z;
    unsigned sum, cnt, mine, sp = 0u;
    for (;;) {
        sum = 0u; cnt = 0u; mine = 0u;
#pragma unroll
        for (unsigned j = 0; j < 16; ++j) { const unsigned c = xb_ld(&bar[XB_XCNT(j)]); sum += c; cnt += (c > 0u) ? 1u : 0u; mine = (j == x) ? c : mine; }
        if (sum == G) break;
        __builtin_amdgcn_s_sleep(1);
        if ((++sp & 255u) == 0u) { if (xb_ld(&bar[XB_TMO])) break; if (sp > XB_SPIN_CAP) { atomicAdd(&bar[XB_TMO], 1u); break; } }
    }
    nloc = mine > 0u ? mine : 1u; nx = cnt > 0u ? cnt : 1u;
}

__device__ __forceinline__ void xcd_barrier(const XcdBarrier& b) {
    asm volatile("s_waitcnt vmcnt(0)" ::: "memory");
    __syncthreads();
    if (threadIdx.x == 0) {
        unsigned* bar = b.bar;
        __builtin_amdgcn_s_waitcnt(0);
        unsigned nloc = b.st[0], nx = b.st[1];
        if (nloc == 0u) { xcd_barrier_complete(bar, b.x, nloc, nx); b.st[0] = nloc; b.st[1] = nx; }
        const unsigned old = xb_add(&bar[XB_XSUB(b.x)], 1u);
        const unsigned gen = old / nloc;
        if (old + 1u == (gen + 1u) * nloc) {
            __builtin_amdgcn_fence(__ATOMIC_RELEASE, "agent");
            asm volatile("s_waitcnt vmcnt(0)" ::: "memory");
            const unsigned og = xb_add(&bar[XB_TOP], 1u);
            const unsigned tg = og / nx;
            if (og + 1u == (tg + 1u) * nx) xb_add(&bar[XB_TOPGEN], 1u);
            else XB_SPIN(xb_ld(&bar[XB_TOPGEN]) == tg, bar);
            __builtin_amdgcn_fence(__ATOMIC_ACQUIRE, "agent");
            xb_add(&bar[XB_XGEN(b.x)], 1u);
            asm volatile("s_waitcnt vmcnt(0)" ::: "memory");
        } else {
            XB_SPIN(xb_ld(&bar[XB_XGEN(b.x)]) == gen, bar);
            __builtin_amdgcn_fence(__ATOMIC_ACQUIRE, "agent");
            asm volatile("s_waitcnt vmcnt(0)" ::: "memory");
        }
    }
    __syncthreads();
}

constexpr int MISC_OFF = LDS_BYTES - 64;
constexpr int CW_BAR = 4096;

__device__ __forceinline__ float bf2f(unsigned v) { return __uint_as_float(v << 16); }
__device__ __forceinline__ unsigned pk2(float lo, float hi) { return pg8::cvt_pk_bf16(lo, hi); }
__device__ __forceinline__ float sigmoidf_(float x) { return __builtin_amdgcn_rcpf(1.0f + __expf(-x)); }
__device__ __forceinline__ float siluf_(float x) { return x * sigmoidf_(x); }
__device__ __forceinline__ float geluf_(float x) { const float z = 1.5957691216057308f * (x + 0.044715f * x * x * x); return x * sigmoidf_(z); }
__device__ __forceinline__ void lds_wait() { asm volatile("s_waitcnt lgkmcnt(0)" ::: "memory"); }
__device__ __forceinline__ void unpack8(u32x4 v, float* f) {
    f[0] = __uint_as_float(v.x << 16); f[1] = __uint_as_float(v.x & 0xffff0000u); f[2] = __uint_as_float(v.y << 16); f[3] = __uint_as_float(v.y & 0xffff0000u);
    f[4] = __uint_as_float(v.z << 16); f[5] = __uint_as_float(v.z & 0xffff0000u); f[6] = __uint_as_float(v.w << 16); f[7] = __uint_as_float(v.w & 0xffff0000u);
}
__device__ __forceinline__ float row_rstd(const float* ssq, int row) {
    const f32x4* p = (const f32x4*)(ssq + (size_t)row * 16);
    const f32x4 a = p[0], b = p[1], c = p[2], d = p[3];
    const float s = ((a.x + a.y) + (a.z + a.w)) + ((b.x + b.y) + (b.z + b.w)) + ((c.x + c.y) + (c.z + c.w)) + ((d.x + d.y) + (d.z + d.w));
    return rsqrtf(s * (1.0f / DM) + EPS);
}
__device__ __forceinline__ void rows_rstd(LAS unsigned char* sl, int rl0, int fq, float (&rs)[8]) {
    f32x4 v[8];
#pragma unroll
    for (int i = 0; i < 8; ++i) v[i] = *(const LAS f32x4*)(sl + (rl0 + (i >> 2) * 128 + (i & 3) * 16) * 64 + fq * 16);
#pragma unroll
    for (int i = 0; i < 8; ++i) { float s = (v[i].x + v[i].y) + (v[i].z + v[i].w); s += __shfl_xor(s, 16); s += __shfl_xor(s, 32); rs[i] = rsqrtf(s * (1.0f / DM) + EPS); }
}
#define MFMA16(X, Y, ACC) ACC = __builtin_amdgcn_mfma_f32_16x16x32_bf16(X, Y, ACC, 0, 0, 0)

struct EpiGU {
    static constexpr bool PERM = true, AFTER_DRAIN = false;
    bf16* H; const float* ssq;
    struct Pre {};
    __device__ __forceinline__ Pre issue(const pg8::Unit&, int, int, int, int) const { return Pre{}; }
    __device__ __forceinline__ void finish(f32x4 (&acc)[2][2][4][2], const Pre&) const {
#pragma unroll
        for (int a = 0; a < 2; ++a)
#pragma unroll
            for (int b = 0; b < 2; ++b)
#pragma unroll
                for (int m = 0; m < 4; ++m)
#pragma unroll
                    for (int n = 0; n < 2; ++n) acc[a][b][m][n] = (f32x4){0.f, 0.f, 0.f, 0.f};
    }
    LAS unsigned char* sl;
    __device__ __forceinline__ void pre(const pg8::Unit& u, int wid, int lane) const {
#pragma unroll
        for (int i = 0; i < 2; ++i) __builtin_amdgcn_global_load_lds((const unsigned*)(ssq + (size_t)(u.pm * 256 + wid * 32 + i * 16 + (lane >> 2)) * 16 + (lane & 3) * 4), (LAS unsigned*)(sl + (wid * 32 + i * 16) * 64), 16, 0, 0);
    }
    __device__ __forceinline__ void operator()(const f32x4 (&acc)[2][2][4][2], const pg8::Unit& u, int wr, int wc, int fr, int fq) const {
        const int row0 = u.pm * 256 + wr * 64 + fr, col0 = u.pn * 128 + wc * 32 + 8 * fq;
        float rs[8]; rows_rstd(sl, wr * 64 + fr, fq, rs);
#pragma unroll
        for (int ai = 0; ai < 2; ++ai)
#pragma unroll
            for (int m = 0; m < 4; ++m) {
                const int row = row0 + ai * 128 + m * 16; const float r = rs[ai * 4 + m];
                float h[8];
#pragma unroll
                for (int n = 0; n < 2; ++n)
#pragma unroll
                    for (int j = 0; j < 4; ++j) { const float g = acc[ai][0][m][n][j] * r, up = acc[ai][1][m][n][j] * r; h[n * 4 + j] = siluf_(g) * up; }
                u32x4 w; w.x = pk2(h[0], h[1]); w.y = pk2(h[2], h[3]); w.z = pk2(h[4], h[5]); w.w = pk2(h[6], h[7]);
                *(u32x4*)(H + (size_t)row * FF + col0) = w;
            }
    }
};
struct EpiRes {
    static constexpr bool PERM = true, AFTER_DRAIN = false;
    bf16* XB; float* ssq; float alpha, inv_alpha;
    struct Pre { u32x4 v[2][4][2]; };
    __device__ __forceinline__ void pre(const pg8::Unit&, int, int) const {}
    __device__ __forceinline__ Pre issue(const pg8::Unit& u, int wr, int wc, int fr, int fq) const {
        Pre p; const int row0 = u.pm * 256 + wr * 64 + fr, colb = u.pn * 256 + wc * 32 + 8 * fq;
#pragma unroll
        for (int ai = 0; ai < 2; ++ai)
#pragma unroll
            for (int m = 0; m < 4; ++m)
#pragma unroll
                for (int bj = 0; bj < 2; ++bj) p.v[ai][m][bj] = *(const u32x4*)(XB + (size_t)(row0 + ai * 128 + m * 16) * DM + colb + bj * 128);
        return p;
    }
    __device__ __forceinline__ void finish(f32x4 (&acc)[2][2][4][2], const Pre& p) const {
#pragma unroll
        for (int ai = 0; ai < 2; ++ai)
#pragma unroll
            for (int m = 0; m < 4; ++m)
#pragma unroll
                for (int bj = 0; bj < 2; ++bj) { float f[8]; unpack8(p.v[ai][m][bj], f);
                    acc[ai][bj][m][0] = (f32x4){f[0], f[1], f[2], f[3]} * inv_alpha; acc[ai][bj][m][1] = (f32x4){f[4], f[5], f[6], f[7]} * inv_alpha; }
    }
    __device__ __forceinline__ void operator()(const f32x4 (&acc)[2][2][4][2], const pg8::Unit& u, int wr, int wc, int fr, int fq) const {
        const int row0 = u.pm * 256 + wr * 64 + fr, colb = u.pn * 256 + wc * 32 + 8 * fq;
#pragma unroll
        for (int ai = 0; ai < 2; ++ai)
#pragma unroll
            for (int m = 0; m < 4; ++m) {
                const int row = row0 + ai * 128 + m * 16;
                float ss = 0.f;
#pragma unroll
                for (int bj = 0; bj < 2; ++bj) {
                    const f32x4 x0 = acc[ai][bj][m][0] * alpha, x1 = acc[ai][bj][m][1] * alpha;
                    u32x4 w; w.x = pk2(x0.x, x0.y); w.y = pk2(x0.z, x0.w); w.z = pk2(x1.x, x1.y); w.w = pk2(x1.z, x1.w);
                    *(u32x4*)(XB + (size_t)row * DM + colb + bj * 128) = w;
                    ss += (x0.x * x0.x + x0.y * x0.y) + (x0.z * x0.z + x0.w * x0.w) + (x1.x * x1.x + x1.y * x1.y) + (x1.z * x1.z + x1.w * x1.w);
                }
                ss += __shfl_xor(ss, 16); ss += __shfl_xor(ss, 32);
                if (fq == 0) ssq[(size_t)row * 16 + u.pn * 4 + wc] = ss;
            }
    }
};
struct EpiWin {
    static constexpr bool PERM = true, AFTER_DRAIN = false;
    bf16* Z; const float* ssq; const float* rcos; const float* rsin;
    struct Pre {};
    __device__ __forceinline__ Pre issue(const pg8::Unit&, int, int, int, int) const { return Pre{}; }
    __device__ __forceinline__ void finish(f32x4 (&acc)[2][2][4][2], const Pre&) const {
#pragma unroll
        for (int a = 0; a < 2; ++a)
#pragma unroll
            for (int b = 0; b < 2; ++b)
#pragma unroll
                for (int m = 0; m < 4; ++m)
#pragma unroll
                    for (int n = 0; n < 2; ++n) acc[a][b][m][n] = (f32x4){0.f, 0.f, 0.f, 0.f};
    }
    LAS unsigned char* sl;
    __device__ __forceinline__ void pre(const pg8::Unit& u, int wid, int lane) const {
#pragma unroll
        for (int i = 0; i < 2; ++i) __builtin_amdgcn_global_load_lds((const unsigned*)(ssq + (size_t)(u.pm * 256 + wid * 32 + i * 16 + (lane >> 2)) * 16 + (lane & 3) * 4), (LAS unsigned*)(sl + (wid * 32 + i * 16) * 64), 16, 0, 0);
    }
    __device__ __forceinline__ void operator()(const f32x4 (&acc)[2][2][4][2], const pg8::Unit& u, int wr, int wc, int fr, int fq) const {
        const int row0 = u.pm * 256 + wr * 64 + fr, pn = u.pn;
        float rs[8]; rows_rstd(sl, wr * 64 + fr, fq, rs);
        if (pn >= 1 && pn <= 4) {
            const float qs = (pn <= 2) ? 0.08838834764831845f : 1.0f;
            const int dd0 = 32 * (wc & 1) + 8 * fq, hh = wc >> 1;
#pragma unroll
            for (int ab = 0; ab < 4; ++ab) { const int ai = ab >> 1, mb = (ab & 1) * 2;
                f32x4 cs[4][4];
#pragma unroll
                for (int m = mb; m < mb + 2; ++m) { const int pos = (row0 + ai * 128 + m * 16) & (SEQ - 1); const float* cp = rcos + pos * 64 + dd0; const float* sp = rsin + pos * 64 + dd0;
                    cs[m][0] = *(const f32x4*)cp; cs[m][1] = *(const f32x4*)(cp + 4); cs[m][2] = *(const f32x4*)sp; cs[m][3] = *(const f32x4*)(sp + 4); }
#pragma unroll
                for (int m = mb; m < mb + 2; ++m) {
                    const int row = row0 + ai * 128 + m * 16; const float r = rs[ai * 4 + m] * qs;
                    const f32x4 c0 = cs[m][0], c1 = cs[m][1], s0 = cs[m][2], s1 = cs[m][3];
                    const f32x4 ta = acc[ai][0][m][0] * r, tb = acc[ai][0][m][1] * r, ua = acc[ai][1][m][0] * r, ub = acc[ai][1][m][1] * r;
                    const f32x4 o1a = ta * c0 - ua * s0, o1b = tb * c1 - ub * s1, o2a = ta * s0 + ua * c0, o2b = tb * s1 + ub * c1;
                    bf16* zp = Z + (size_t)row * IW + pn * 256 + hh * 128 + dd0;
                    u32x4 w1, w2;
                    w1.x = pk2(o1a.x, o1a.y); w1.y = pk2(o1a.z, o1a.w); w1.z = pk2(o1b.x, o1b.y); w1.w = pk2(o1b.z, o1b.w);
                    w2.x = pk2(o2a.x, o2a.y); w2.y = pk2(o2a.z, o2a.w); w2.z = pk2(o2b.x, o2b.y); w2.w = pk2(o2b.z, o2b.w);
                    *(u32x4*)zp = w1; *(u32x4*)(zp + 64) = w2;
                }
                asm volatile("" ::: "memory");
            }
        } else {
            const int act = (pn == 7 || pn == 8) ? 1 : (pn == 10 ? 2 : 0);
#pragma unroll
            for (int ai = 0; ai < 2; ++ai)
#pragma unroll
                for (int m = 0; m < 4; ++m) {
                    const int row = row0 + ai * 128 + m * 16; const float r = rs[ai * 4 + m];
#pragma unroll
                    for (int bj = 0; bj < 2; ++bj) {
                        float v[8];
#pragma unroll
                        for (int n = 0; n < 2; ++n)
#pragma unroll
                            for (int j = 0; j < 4; ++j) { float t = acc[ai][bj][m][n][j] * r; if (act == 1) t = siluf_(t); else if (act == 2) t = geluf_(t); v[n * 4 + j] = t; }
                        u32x4 w; w.x = pk2(v[0], v[1]); w.y = pk2(v[2], v[3]); w.z = pk2(v[4], v[5]); w.w = pk2(v[6], v[7]);
                        *(u32x4*)(Z + (size_t)row * IW + pn * 256 + bj * 128 + wc * 32 + 8 * fq) = w;
                    }
                }
        }
    }
};

__device__ __forceinline__ void transpose_item(const float* W, int N, bf16* WT, int K, int k0, int n0, int drow0, const float* gk, LAS float* scr, int lane) {
    float wv[32];
#pragma unroll
    for (int i = 0; i < 32; ++i) wv[i] = W[(size_t)(k0 + 2 * i + (lane >> 5)) * N + n0 + (lane & 31)];
#pragma unroll
    for (int i = 0; i < 32; ++i) { const int kk = 2 * i + (lane >> 5); float v = wv[i]; if (gk) v *= gk[kk]; scr[kk * 33 + (lane & 31)] = v; }
    lds_wait();
    const int c = lane & 7;
#pragma unroll
    for (int j = 0; j < 4; ++j) { const int n = (lane >> 3) + 8 * j; const LAS float* s = scr + (8 * c) * 33 + n;
        u32x4 o; o.x = pk2(s[0 * 33], s[1 * 33]); o.y = pk2(s[2 * 33], s[3 * 33]); o.z = pk2(s[4 * 33], s[5 * 33]); o.w = pk2(s[6 * 33], s[7 * 33]);
        *(u32x4*)(WT + (size_t)(drow0 + n) * K + k0 + 8 * c) = o; }
    lds_wait();
}
constexpr int IT_BIG = 1408, IT_OUT = 512, IT_GLU = 32, IT_LW = 8;
constexpr int IT_LAYER = 7 * IT_BIG + IT_OUT + IT_GLU + 2 * IT_LW;
__device__ __forceinline__ void p0_weight_item(const Args& a, int l, int r, LAS float* scr, int lane) {
    unsigned char* wl = a.ws + WS_W + (size_t)l * WL_STRIDE;
#pragma unroll
    for (int f = 0; f < 2; ++f) {
        const float* nrm = a.in[f ? 28 : 1] + (size_t)l * DM;
        bf16* gu = (bf16*)(wl + (f ? WL_GU2 : WL_GU1)); bf16* dn = (bf16*)(wl + (f ? WL_D2 : WL_D1));
        if (r < 2 * IT_BIG) { const int up = r >= IT_BIG; const int it = r - up * IT_BIG; const int kb = it / 88, nb = it % 88, k0 = 64 * kb, n0 = 32 * nb;
            const float* W = a.in[(f ? 29 : 2) + up] + (size_t)l * DM * FF;
            transpose_item(W, FF, gu, DM, k0, n0, (n0 >> 7) * 256 + up * 128 + (n0 & 127), nrm + k0, scr, lane); return; }
        r -= 2 * IT_BIG;
        if (r < IT_BIG) { const int kb = r / 32, nb = r % 32; const float* W = a.in[f ? 31 : 4] + (size_t)l * FF * DM;
            transpose_item(W, DM, dn, FF, 64 * kb, 32 * nb, 32 * nb, nullptr, scr, lane); return; }
        r -= IT_BIG;
    }
    if (r < IT_BIG) {
        const int kb = r / 88, nb = r % 88, k0 = 64 * kb, n0 = 32 * nb; const int tile = n0 >> 8, c0 = n0 & 255;
        int drow = n0;
        if (tile >= 1 && tile <= 4) { const int hh = c0 >> 7, d0 = c0 & 127, bj = d0 >> 6, dd0 = d0 & 63; drow = tile * 256 + bj * 128 + hh * 64 + dd0; }
        transpose_item(a.in[6] + (size_t)l * DM * IW, IW, (bf16*)(wl + WL_WIN), DM, k0, n0, drow, a.in[5] + (size_t)l * DM + k0, scr, lane); return; }
    r -= IT_BIG;
    if (r < IT_OUT) {
        const int kb = r / 32, nb = r % 32, k0 = 64 * kb;
        const float* gk = (k0 < 256) ? a.in[17] + (size_t)l * 256 + k0 : (k0 < 768 ? a.in[18] + (size_t)l * 512 + (k0 - 256) : a.in[26] + (size_t)l * 256 + (k0 - 768));
        transpose_item(a.in[27] + (size_t)l * DM * DM, DM, (bf16*)(wl + WL_WOUT), DM, k0, 32 * nb, 32 * nb, gk, scr, lane); return; }
    r -= IT_OUT;
    if (r < IT_GLU) { const int kb = r / 8, nb = r % 8; transpose_item(a.in[15] + (size_t)l * 65536, 256, (bf16*)(wl + WL_GLU), 256, 64 * kb, 32 * nb, 32 * nb, nullptr, scr, lane); return; }
    r -= IT_GLU;
    if (r < IT_LW) { const int blk = r >> 1, nb = r & 1; transpose_item(a.in[21] + (size_t)l * 16384 + blk * 4096, 64, (bf16*)(wl + WL_WA) + blk * 4096, 64, 0, 32 * nb, 32 * nb, nullptr, scr, lane); return; }
    r -= IT_LW;
    { const int blk = r >> 1, nb = r & 1; transpose_item(a.in[23] + (size_t)l * 16384 + blk * 4096, 64, (bf16*)(wl + WL_WX) + blk * 4096, 64, 0, 32 * nb, 32 * nb, nullptr, scr, lane); }
}
__device__ __forceinline__ float wave_sum(float v) {
#pragma unroll
    for (int o = 1; o < 64; o <<= 1) v += __shfl_xor(v, o);
    return v;
}
__device__ __forceinline__ void p0_prologue(const Args& a, LAS unsigned char* lds, int tid, int lane, int wave, int G) {
    LAS float* scr = (LAS float*)(lds + wave * 8448);
    const int gw = blockIdx.x * NWAVE + wave, NGW = G * NWAVE;
    for (int it = gw; it < (G == 256 ? 1 : NL) * IT_LAYER; it += NGW) p0_weight_item(a, it / IT_LAYER, it % IT_LAYER, scr, lane);
    const float* x = a.in[0]; bf16* xb = (bf16*)(a.ws + WS_XB); float* ssq = (float*)(a.ws + WS_SSQ);
    for (int m = gw; m < NTOK; m += NGW) {
        const f32x4* xr = (const f32x4*)(x + (size_t)m * DM) + lane; u32x2* brow = (u32x2*)(xb + (size_t)m * DM) + lane;
        float s = 0.f;
#pragma unroll
        for (int j = 0; j < 4; ++j) { const f32x4 v = xr[64 * j]; u32x2 w; w.x = pk2(v.x, v.y); w.y = pk2(v.z, v.w); brow[64 * j] = w; s += (v.x * v.x + v.y * v.y) + (v.z * v.z + v.w * v.w); }
        s = wave_sum(s);
        if (lane < 16) ssq[(size_t)m * 16 + lane] = (lane == 0) ? s : 0.f;
    }
    const int gt = blockIdx.x * NTHR + tid, NGT = G * NTHR;
    float* rcos = (float*)(a.ws + WS_ROPE); float* rsin = rcos + SEQ * 64;
    for (int i = gt; i < SEQ * 64; i += NGT) { const int pos = i >> 6, k = i & 63; const float inv = powf(10000.0f, -(float)(2 * k) / 128.0f); const float ang = (float)pos * inv; rcos[i] = cosf(ang); rsin[i] = sinf(ang); }
    for (int i = gt; i < NL * 16 * 64; i += NGT) {
        const int p = i & 63, lg = i >> 6, l = lg >> 4, g = lg & 15;
        const float lre = a.in[7][i], lim = a.in[8][i], step = expf(a.in[9][lg]);
        const float ar = lre * step, ai = lim * step, mag = expf(ar), lbr = mag * cosf(ai), lbi = mag * sinf(ai);
        const float nr = lbr - 1.0f, den = lre * lre + lim * lim, fr = (nr * lre + lbi * lim) / den, fi = (lbi * lre - nr * lim) / den;
        float* tab = (float*)(a.ws + WS_W + (size_t)l * WL_STRIDE + WL_S5T) + (size_t)g * 36 * 64 + p;
        float cr = lbr, ci = lbi;
#pragma unroll
        for (int q = 0; q < 6; ++q) { const float t = cr * cr - ci * ci; ci = 2.0f * cr * ci; cr = t; }
        tab[0] = lbr; tab[64] = lbi; tab[128] = cr; tab[192] = ci;
        for (int h = 0; h < 16; ++h) { const float br = a.in[10][(size_t)i * 16 + h], bi = a.in[11][(size_t)i * 16 + h]; const float bbr = fr * br - fi * bi, bbi = fr * bi + fi * br; tab[(4 + h) * 64] = bbr; tab[(20 + h) * 64] = bbi;
            bf16* BB = (bf16*)(a.ws + WS_W + (size_t)l * WL_STRIDE + WL_BB); const unsigned pr = pk2(bbr, bbi);
            BB[(size_t)(g * 128 + p) * 16 + h] = (bf16)(pr & 0xffffu); BB[(size_t)(g * 128 + 64 + p) * 16 + h] = (bf16)(pr >> 16); }
    }
    for (int i = gt; i < NL * 16 * 16 * 128; i += NGT) {
        const int k = i & 127, lgh = i >> 7, l = lgh >> 8;
        const float v = (k < 64) ? a.in[12][(size_t)lgh * 64 + k] : -a.in[13][(size_t)lgh * 64 + (k - 64)];
        ((bf16*)(a.ws + WS_W + (size_t)l * WL_STRIDE + WL_CM))[i & 32767] = (bf16)(pk2(v, 0.f) & 0xffffu);
    }
    for (int i = gt; i < NL * 256; i += NGT) { const float lam = a.in[25][i]; const float sp = (lam > 15.f) ? expf(-lam) : log1pf(expf(-lam)); ((float*)(a.ws + WS_TAB))[i] = -8.0f * sp; }
}

__device__ __forceinline__ void tail_convert(const Args& a, int l, int slot, LAS unsigned char* lds) {
    if (l >= NL) return;
    int tid = threadIdx.x; asm volatile("" : "+v"(tid)); const int lane = tid & 63, wave = __builtin_amdgcn_readfirstlane(tid >> 6);
    LAS float* scr = (LAS float*)(lds + wave * 8448);
    for (int it = slot * NWAVE + wave; it < IT_LAYER; it += 320 * NWAVE) p0_weight_item(a, l, it, scr, lane);
    __syncthreads();
}
constexpr int OFF_BUS = 0, BUS_WAVE = 8448, OFF_SST = 67584, SST_WAVE = 4352, OFF_YS = 102400, OFF_RED2 = 136192;
template <bool FULL> __device__ __forceinline__ void s5_group(const Args& a, int l, int tile, int g, LAS unsigned char* lds, int lane, int wave) {
    const bf16* Z = (const bf16*)(a.ws + WS_HZ);
    const int t0 = tile * 64, fr = lane & 15, fq = lane >> 4;
    unsigned char* wl = a.ws + WS_W + (size_t)l * WL_STRIDE;
    const float* tab = (const float*)(wl + WL_S5T) + (size_t)g * 36 * 64; const bf16* BB = (const bf16*)(wl + WL_BB); const bf16* CM = (const bf16*)(wl + WL_CM);
    float* E = (float*)(a.ws + WS_S5E);
    LAS unsigned char* bus = lds + OFF_BUS + wave * BUS_WAVE; LAS unsigned char* sst = lds + OFF_SST + wave * SST_WAVE;
    const float lbr = tab[lane], lbi = tab[64 + lane];
    const bf16x8 zero8 = {0, 0, 0, 0, 0, 0, 0, 0};
    bf16x8 bbf[8];
#pragma unroll
    for (int kt = 0; kt < 8; ++kt) { bbf[kt] = zero8; if (fq < 2) bbf[kt] = *(const bf16x8*)(BB + (size_t)(g * 128 + kt * 16 + fr) * 16 + 8 * fq); }
    float sre = 0.f, sim = 0.f;
    bf16x8 cm[4]; f32x4 dsk;
    if (FULL) {
        sre = E[((size_t)(tile * 16 + g) * 2 + 0) * 64 + lane]; sim = E[((size_t)(tile * 16 + g) * 2 + 1) * 64 + lane];
#pragma unroll
        for (int ks = 0; ks < 4; ++ks) cm[ks] = *(const bf16x8*)(CM + (size_t)(g * 16 + fr) * 128 + 32 * ks + 8 * fq);
        dsk = *(const f32x4*)(a.in[14] + (size_t)l * 256 + g * 16 + 4 * fq);
    }
    bf16x8 ufa[4]; u32x2 urawa[4];
#pragma unroll
    for (int tb = 0; tb < 4; ++tb) { const bf16* zr = Z + (size_t)(t0 + tb * 16 + fr) * IW + g * 16;
        ufa[tb] = zero8; if (fq < 2) ufa[tb] = *(const bf16x8*)(zr + 8 * fq);
        if (FULL) urawa[tb] = *(const u32x2*)(zr + 4 * fq); }
#pragma unroll
    for (int tb = 0; tb < 4; ++tb) {
        const bf16x8 uf = ufa[tb]; u32x2 uraw; if (FULL) uraw = urawa[tb];
#pragma unroll
        for (int kt = 0; kt < 8; ++kt) { f32x4 d = {0.f, 0.f, 0.f, 0.f}; MFMA16(bbf[kt], uf, d); *(LAS f32x4*)(bus + (fr * 132 + kt * 16 + 4 * fq) * 4) = d; }
        lds_wait();
        float bra[16], bia[16];
#pragma unroll
        for (int tt = 0; tt < 16; ++tt) { bra[tt] = *(const LAS float*)(bus + (tt * 132 + lane) * 4); bia[tt] = *(const LAS float*)(bus + (tt * 132 + 64 + lane) * 4); }
#pragma unroll
        for (int tt = 0; tt < 16; ++tt) {
            const float br = bra[tt], bi = bia[tt];
            const float nre = lbr * sre - lbi * sim + br, nim = lbr * sim + lbi * sre + bi; sre = nre; sim = nim;
            if (FULL) { const unsigned pr = pk2(sre, sim);
                *(LAS bf16*)(sst + (tt * 136 + lane) * 2) = (bf16)(pr & 0xffffu); *(LAS bf16*)(sst + (tt * 136 + 64 + lane) * 2) = (bf16)(pr >> 16); }
        }
        if (FULL) {
            lds_wait();
            f32x4 acc = {0.f, 0.f, 0.f, 0.f};
#pragma unroll
            for (int ks = 0; ks < 4; ++ks) { const bf16x8 yv = *(const LAS bf16x8*)(sst + (fr * 136 + 32 * ks + 8 * fq) * 2); MFMA16(cm[ks], yv, acc); }
            const int t = tb * 16 + fr;
            f32x4 u4; u4.x = __uint_as_float(uraw.x << 16); u4.y = __uint_as_float(uraw.x & 0xffff0000u); u4.z = __uint_as_float(uraw.y << 16); u4.w = __uint_as_float(uraw.y & 0xffff0000u);
            const f32x4 v = acc + dsk * u4;
            u32x2 w; w.x = pk2(geluf_(v.x), geluf_(v.y)); w.y = pk2(geluf_(v.z), geluf_(v.w));
            *(LAS u32x2*)(lds + OFF_YS + (t * 264 + g * 16 + 4 * fq) * 2) = w;
        }
        lds_wait();
    }
    if (!FULL) { E[((size_t)(tile * 16 + g) * 2 + 0) * 64 + lane] = sre; E[((size_t)(tile * 16 + g) * 2 + 1) * 64 + lane] = sim; }
}
__device__ __forceinline__ void s5_m1(const Args& a, int l, int tile, LAS unsigned char* lds, int tid, int lane, int wave) {
    for (int gi = 0; gi < 2; ++gi) s5_group<false>(a, l, tile, wave * 2 + gi, lds, lane, wave);
    __syncthreads();
}
__device__ __forceinline__ void s5_m3(const Args& a, int l, int tile, LAS unsigned char* lds, int tid, int lane, int wave) {
    bf16* Y = (bf16*)(a.ws + WS_Y);
    const int t0 = tile * 64, fr = lane & 15, fq = lane >> 4;
    unsigned char* wl = a.ws + WS_W + (size_t)l * WL_STRIDE;
    for (int gi = 0; gi < 2; ++gi) s5_group<true>(a, l, tile, wave * 2 + gi, lds, lane, wave);
    __syncthreads();
    {
        const int cb = wave & 3, jh = wave >> 2; const bf16* WG = (const bf16*)(wl + WL_GLU);
        f32x4 acc[8];
#pragma unroll
        for (int jt = 0; jt < 8; ++jt) acc[jt] = (f32x4){0.f, 0.f, 0.f, 0.f};
#pragma unroll
        for (int ks = 0; ks < 8; ++ks) {
            const bf16x8 yv = *(const LAS bf16x8*)(lds + OFF_YS + ((cb * 16 + fr) * 264 + 32 * ks + 8 * fq) * 2);
#pragma unroll
            for (int jt = 0; jt < 8; ++jt) { const bf16x8 wv = *(const bf16x8*)(WG + (size_t)(jh * 128 + jt * 16 + fr) * 256 + 32 * ks + 8 * fq); MFMA16(wv, yv, acc[jt]); }
        }
        const int t = cb * 16 + fr; float ss = 0.f;
#pragma unroll
        for (int jt = 0; jt < 8; ++jt) {
            const int j0 = jh * 128 + jt * 16 + 4 * fq;
            const f32x4 bg = *(const f32x4*)(a.in[16] + (size_t)l * 256 + j0);
            const u32x2 yr = *(const LAS u32x2*)(lds + OFF_YS + (t * 264 + j0) * 2);
            f32x4 o;
            o.x = __uint_as_float(yr.x << 16) * sigmoidf_(acc[jt].x + bg.x); o.y = __uint_as_float(yr.x & 0xffff0000u) * sigmoidf_(acc[jt].y + bg.y);
            o.z = __uint_as_float(yr.y << 16) * sigmoidf_(acc[jt].z + bg.z); o.w = __uint_as_float(yr.y & 0xffff0000u) * sigmoidf_(acc[jt].w + bg.w);
            acc[jt] = o; ss += (o.x * o.x + o.y * o.y) + (o.z * o.z + o.w * o.w);
        }
        ss += __shfl_xor(ss, 16); ss += __shfl_xor(ss, 32);
        LAS float* red = (LAS float*)(lds + OFF_RED2);
        if (fq == 0) red[t * 2 + jh] = ss;
        __syncthreads();
        const float rstd = rsqrtf((red[t * 2] + red[t * 2 + 1]) * (1.0f / 256.0f) + EPS);
#pragma unroll
        for (int jt = 0; jt < 8; ++jt) { const int j0 = jh * 128 + jt * 16 + 4 * fq; u32x2 w; w.x = pk2(acc[jt].x * rstd, acc[jt].y * rstd); w.y = pk2(acc[jt].z * rstd, acc[jt].w * rstd);
            *(u32x2*)(Y + (size_t)(t0 + t) * DM + j0) = w; }
    }
    __syncthreads();
}

constexpr int OFF_LA = 0, OFF_LB = 65536, OFF_XC = 65536;
template <bool FULL> __device__ __forceinline__ void lru_tile(const Args& a, int l, int tile, LAS unsigned char* lds, int tid, int lane, int wave) {
    const bf16* Z = (const bf16*)(a.ws + WS_HZ); bf16* Y = (bf16*)(a.ws + WS_Y);
    const int t0 = tile * 64, fr = lane & 15, fq = lane >> 4; const int tloc0 = (tile & 127) * 64;
    unsigned char* wl = a.ws + WS_W + (size_t)l * WL_STRIDE;
#pragma unroll
    for (int it = 0; it < 4; ++it) {
        const int ch = it * NTHR + tid, t = ch >> 5, c8 = ch & 31;
        float xc[8];
        { const f32x4 b0 = *(const f32x4*)(a.in[20] + (size_t)l * 256 + c8 * 8), b1 = *(const f32x4*)(a.in[20] + (size_t)l * 256 + c8 * 8 + 4);
          xc[0] = b0.x; xc[1] = b0.y; xc[2] = b0.z; xc[3] = b0.w; xc[4] = b1.x; xc[5] = b1.y; xc[6] = b1.z; xc[7] = b1.w; }
#pragma unroll
        for (int j = 0; j < 4; ++j) {
            if (tloc0 + t + j - 3 >= 0) {
                const u32x4 v = *(const u32x4*)(Z + (size_t)(t0 + t + j - 3) * IW + 2304 + c8 * 8); float f[8]; unpack8(v, f);
                const f32x4 w0 = *(const f32x4*)(a.in[19] + ((size_t)l * 4 + j) * 256 + c8 * 8), w1 = *(const f32x4*)(a.in[19] + ((size_t)l * 4 + j) * 256 + c8 * 8 + 4);
                xc[0] = fmaf(w0.x, f[0], xc[0]); xc[1] = fmaf(w0.y, f[1], xc[1]); xc[2] = fmaf(w0.z, f[2], xc[2]); xc[3] = fmaf(w0.w, f[3], xc[3]);
                xc[4] = fmaf(w1.x, f[4], xc[4]); xc[5] = fmaf(w1.y, f[5], xc[5]); xc[6] = fmaf(w1.z, f[6], xc[6]); xc[7] = fmaf(w1.w, f[7], xc[7]);
            }
        }
        u32x4 w; w.x = pk2(xc[0], xc[1]); w.y = pk2(xc[2], xc[3]); w.z = pk2(xc[4], xc[5]); w.w = pk2(xc[6], xc[7]);
        *(LAS u32x4*)(lds + OFF_XC + (t * 264 + c8 * 8) * 2) = w;
    }
    __syncthreads();
    {
        const int cb = wave & 3, chh = wave >> 2; const bf16* WA = (const bf16*)(wl + WL_WA); const bf16* WX = (const bf16*)(wl + WL_WX);
        const float* c8t = (const float*)(a.ws + WS_TAB) + (size_t)l * 256;
        f32x4 av[8], bv[8];
#pragma unroll
        for (int et = 0; et < 8; ++et) {
            const int e0 = chh * 128 + et * 16, nb = e0 >> 6, el = e0 & 63;
            f32x4 ra = {0.f, 0.f, 0.f, 0.f}, ia = {0.f, 0.f, 0.f, 0.f};
#pragma unroll
            for (int ks = 0; ks < 2; ++ks) {
                const bf16x8 xv = *(const LAS bf16x8*)(lds + OFF_XC + ((cb * 16 + fr) * 264 + nb * 64 + 32 * ks + 8 * fq) * 2);
                const bf16x8 wa = *(const bf16x8*)(WA + (size_t)nb * 4096 + (el + fr) * 64 + 32 * ks + 8 * fq);
                const bf16x8 wx = *(const bf16x8*)(WX + (size_t)nb * 4096 + (el + fr) * 64 + 32 * ks + 8 * fq);
                MFMA16(wa, xv, ra); MFMA16(wx, xv, ia);
            }
            const int c0 = e0 + 4 * fq;
            const f32x4 ba = *(const f32x4*)(a.in[22] + (size_t)l * 256 + c0), bx = *(const f32x4*)(a.in[24] + (size_t)l * 256 + c0), c8v = *(const f32x4*)(c8t + c0);
            const u32x2 xr = *(const LAS u32x2*)(lds + OFF_XC + ((cb * 16 + fr) * 264 + c0) * 2);
            const float xcv[4] = {__uint_as_float(xr.x << 16), __uint_as_float(xr.x & 0xffff0000u), __uint_as_float(xr.y << 16), __uint_as_float(xr.y & 0xffff0000u)};
#pragma unroll
            for (int r = 0; r < 4; ++r) {
                const float rg = sigmoidf_(ra[r] + ba[r]), ig = sigmoidf_(ia[r] + bx[r]);
                const float la = c8v[r] * rg; const float av_ = __expf(la); const float m2 = -expm1f(2.0f * la);
                av[et][r] = av_; bv[et][r] = sqrtf(fmaxf(m2, 0.f)) * ig * xcv[r];
            }
            if ((et & 3) == 3) asm volatile("" ::: "memory");
        }
        __syncthreads();
#pragma unroll
        for (int et = 0; et < 8; ++et) { const int c0 = chh * 128 + et * 16 + 4 * fq, t = cb * 16 + fr;
            *(LAS f32x4*)(lds + OFF_LA + (t * 256 + c0) * 4) = av[et]; *(LAS f32x4*)(lds + OFF_LB + (t * 256 + c0) * 4) = bv[et]; }
    }
    __syncthreads();
    float* AE = (float*)(a.ws + WS_LRUC); float* HE = AE + 2 * 128 * 256;
    if (tid < 256) {
        LAS float* A = (LAS float*)(lds + OFF_LA) + tid; LAS float* B = (LAS float*)(lds + OFF_LB) + tid;
        float h = FULL ? HE[(size_t)tile * 256 + tid] : 0.f, P = 1.f;
        for (int tb = 0; tb < 64; tb += 16) {
            float av_[16], bv_[16];
#pragma unroll
            for (int j = 0; j < 16; ++j) { av_[j] = A[(tb + j) * 256]; bv_[j] = B[(tb + j) * 256]; }
#pragma unroll
            for (int j = 0; j < 16; ++j) { h = fmaf(av_[j], h, bv_[j]); if (FULL) bv_[j] = h; else P *= av_[j]; }
            if (FULL) {
#pragma unroll
                for (int j = 0; j < 16; ++j) B[(tb + j) * 256] = bv_[j];
            }
        }
        if (!FULL) { AE[(size_t)tile * 256 + tid] = P; HE[(size_t)tile * 256 + tid] = h; }
    }
    __syncthreads();
    if (FULL) {
#pragma unroll
        for (int it = 0; it < 4; ++it) {
            const int ch = it * NTHR + tid, t = ch >> 5, c8 = ch & 31;
            const LAS f32x4* hp = (const LAS f32x4*)(lds + OFF_LB + (t * 256 + c8 * 8) * 4); const f32x4 h0 = hp[0], h1 = hp[1];
            const u32x4 gv = *(const u32x4*)(Z + (size_t)(t0 + t) * IW + 2560 + c8 * 8); float g[8]; unpack8(gv, g);
            float o[8] = {h0.x * g[0], h0.y * g[1], h0.z * g[2], h0.w * g[3], h1.x * g[4], h1.y * g[5], h1.z * g[6], h1.w * g[7]};
            float ss = 0.f;
#pragma unroll
            for (int i = 0; i < 8; ++i) ss += o[i] * o[i];
#pragma unroll
            for (int s = 1; s < 32; s <<= 1) ss += __shfl_xor(ss, s);
            const float rstd = rsqrtf(ss * (1.0f / 256.0f) + EPS);
            u32x4 w; w.x = pk2(o[0] * rstd, o[1] * rstd); w.y = pk2(o[2] * rstd, o[3] * rstd); w.z = pk2(o[4] * rstd, o[5] * rstd); w.w = pk2(o[6] * rstd, o[7] * rstd);
            *(u32x4*)(Y + (size_t)(t0 + t) * DM + 768 + c8 * 8) = w;
        }
        __syncthreads();
    }
}

constexpr int OFF_QS = 0, OFF_KS = 17408, OFF_VT = 52224, OFF_PT = 87040, OFF_SS = 121856, OFF_RED = 139264;
__device__ __forceinline__ float ret_lg2(int h) { return log2f(1.0f - exp2f(-5.0f - (float)h)); }
typedef short s16x4 __attribute__((ext_vector_type(4)));
__device__ __forceinline__ bf16x8 tr_frag(LAS unsigned char* base, int stride, int k0, int c0, int lane) {
    const int fq = lane >> 4, q = (lane & 15) >> 2, p = lane & 3;
    LAS unsigned char* a0 = base + (k0 + 8 * fq + q) * stride + (c0 + 4 * p) * 2;
    const s16x4 lo = __builtin_amdgcn_ds_read_tr16_b64_v4i16((LAS s16x4*)a0);
    const s16x4 hi = __builtin_amdgcn_ds_read_tr16_b64_v4i16((LAS s16x4*)(a0 + 4 * stride));
    return (bf16x8){lo[0], lo[1], lo[2], lo[3], hi[0], hi[1], hi[2], hi[3]};
}
template <int NR, bool ZETA> __device__ __forceinline__ void ret_load_R(const bf16* Z, int r0, int c0, LAS unsigned char* dst, int tid, float lg2) {
#pragma unroll
    for (int it = 0; it < NR / 32; ++it) { const int ch = it * NTHR + tid, r = ch >> 4, c = ch & 15;
        u32x4 v = *(const u32x4*)(Z + (size_t)(r0 + r) * IW + c0 + c * 8);
        if (ZETA) { const float zs = exp2f((float)(127 - r) * lg2); float f[8]; unpack8(v, f);
            v.x = pk2(f[0] * zs, f[1] * zs); v.y = pk2(f[2] * zs, f[3] * zs); v.z = pk2(f[4] * zs, f[5] * zs); v.w = pk2(f[6] * zs, f[7] * zs); }
        *(LAS u32x4*)(dst + (r * 136 + c * 8) * 2) = v; }
}
template <bool ZETA> __device__ __forceinline__ void ret_load_T(const bf16* Z, int r0, int c0, LAS unsigned char* dst, int tid, float lg2) {
    const int m = tid & 127; const float zs = ZETA ? exp2f((float)(127 - m) * lg2) : 1.0f;
#pragma unroll
    for (int it = 0; it < 4; ++it) { const int dc = (tid >> 7) + 4 * it;
        const u32x4 v = *(const u32x4*)(Z + (size_t)(r0 + m) * IW + c0 + dc * 8); float f[8]; unpack8(v, f);
#pragma unroll
        for (int i = 0; i < 8; i += 2) { const unsigned pr = pk2(f[i] * zs, f[i + 1] * zs);
            *(LAS bf16*)(dst + ((dc * 8 + i) * 136 + m) * 2) = (bf16)(pr & 0xffffu); *(LAS bf16*)(dst + ((dc * 8 + i + 1) * 136 + m) * 2) = (bf16)(pr >> 16); }
    }
}
__device__ __forceinline__ void ret_kv(const Args& a, int unit, LAS unsigned char* lds, int tid, int lane, int wave) {
    const bf16* Z = (const bf16*)(a.ws + WS_HZ);
    const int n = unit & 63, bh = unit >> 6, h = bh & 3, b = bh >> 2, r0 = b * SEQ + n * 128, fr = lane & 15, fq = lane >> 4;
    const float lg2 = ret_lg2(h);
    ret_load_R<128, true>(Z, r0, 768 + h * 128, lds + OFF_KS, tid, lg2);
    ret_load_R<128, false>(Z, r0, 1280 + h * 128, lds + OFF_VT, tid, lg2);
    __syncthreads();
    const int eb = (wave & 3) * 32, dh = (wave >> 2) * 64;
    f32x4 acc[2][4];
#pragma unroll
    for (int i = 0; i < 2; ++i)
#pragma unroll
        for (int j = 0; j < 4; ++j) acc[i][j] = (f32x4){0.f, 0.f, 0.f, 0.f};
#pragma unroll
    for (int ks = 0; ks < 4; ++ks) {
        bf16x8 vf[2], kf[4];
#pragma unroll
        for (int i = 0; i < 2; ++i) vf[i] = tr_frag(lds + OFF_VT, 272, 32 * ks, eb + i * 16, lane);
#pragma unroll
        for (int j = 0; j < 4; ++j) kf[j] = tr_frag(lds + OFF_KS, 272, 32 * ks, dh + j * 16, lane);
#pragma unroll
        for (int i = 0; i < 2; ++i)
#pragma unroll
            for (int j = 0; j < 4; ++j) MFMA16(kf[j], vf[i], acc[i][j]);
        asm volatile("" ::: "memory");
    }
    float* KV = (float*)(a.ws + WS_KV) + (size_t)unit * 16384;
#pragma unroll
    for (int i = 0; i < 2; ++i)
#pragma unroll
        for (int j = 0; j < 4; ++j) *(f32x4*)(KV + (size_t)(eb + i * 16 + fr) * 128 + dh + j * 16 + 4 * fq) = acc[i][j];
    __syncthreads();
}
__device__ __forceinline__ void ret_out(const Args& a, int tile, LAS unsigned char* lds, int tid, int lane, int wave) {
    const bf16* Z = (const bf16*)(a.ws + WS_HZ); bf16* Y = (bf16*)(a.ws + WS_Y); const bf16* PB = (const bf16*)(a.ws + WS_PB);
    const int b = tile >> 7, n = (tile & 127) >> 1, half = tile & 1, t0 = tile * 64, k0 = b * SEQ + n * 128, fr = lane & 15, fq = lane >> 4;
    const int cb = wave & 3, hv = wave >> 2;
    const int cg = half * 64 + cb * 16 + fr;
    const int nit = half ? 4 : 2;
    LAS float* red = (LAS float*)(lds + OFF_RED);
    const int lr = tid >> 4, lc = tid & 15;
    u32x4 rq[2], rk[4], rv[4], rp[4];
#define RET_ISSUE(h_) do { \
        _Pragma("unroll") for (int it = 0; it < 2; ++it) rq[it] = *(const u32x4*)(Z + (size_t)(t0 + it * 32 + lr) * IW + 256 + (h_) * 128 + lc * 8); \
        _Pragma("unroll") for (int it = 0; it < 4; ++it) if (it < nit) { rk[it] = *(const u32x4*)(Z + (size_t)(k0 + it * 32 + lr) * IW + 768 + (h_) * 128 + lc * 8); \
                                                                          rv[it] = *(const u32x4*)(Z + (size_t)(k0 + it * 32 + lr) * IW + 1280 + (h_) * 128 + lc * 8); } \
        { const bf16* P_ = PB + (size_t)(((b * 4 + (h_)) * 64) + n) * 16384; \
          _Pragma("unroll") for (int it = 0; it < 4; ++it) rp[it] = *(const u32x4*)(P_ + (size_t)(it * 32 + lr) * 128 + lc * 8); } } while (0)
    RET_ISSUE(0);
    float ss512 = 0.f;
#pragma unroll 1
    for (int h = 0; h < 4; ++h) {
        const float lg2 = ret_lg2(h);
#pragma unroll
        for (int it = 0; it < 2; ++it) *(LAS u32x4*)(lds + OFF_QS + ((it * 32 + lr) * 136 + lc * 8) * 2) = rq[it];
#pragma unroll
        for (int it = 0; it < 4; ++it) if (it < nit) { *(LAS u32x4*)(lds + OFF_KS + ((it * 32 + lr) * 136 + lc * 8) * 2) = rk[it]; *(LAS u32x4*)(lds + OFF_VT + ((it * 32 + lr) * 136 + lc * 8) * 2) = rv[it]; }
#pragma unroll
        for (int it = 0; it < 4; ++it) *(LAS u32x4*)(lds + OFF_PT + ((it * 32 + lr) * 136 + lc * 8) * 2) = rp[it];
        __syncthreads();
        if (h < 3) RET_ISSUE(h + 1);
        u32x2 gr[4];
#pragma unroll
        for (int et = 0; et < 4; ++et) gr[et] = *(const u32x2*)(Z + (size_t)(t0 + cb * 16 + fr) * IW + 1792 + h * 128 + hv * 64 + et * 16 + 4 * fq);
        if (hv == 0 || half) {
            f32x4 sc[4];
#pragma unroll
            for (int mt = 0; mt < 4; ++mt) sc[mt] = (f32x4){0.f, 0.f, 0.f, 0.f};
#pragma unroll
            for (int ks = 0; ks < 4; ++ks) {
                const bf16x8 qf = *(const LAS bf16x8*)(lds + OFF_QS + ((cb * 16 + fr) * 136 + 32 * ks + 8 * fq) * 2);
#pragma unroll
                for (int mt = 0; mt < 4; ++mt) { const bf16x8 kf = *(const LAS bf16x8*)(lds + OFF_KS + ((hv * 64 + mt * 16 + fr) * 136 + 32 * ks + 8 * fq) * 2); MFMA16(kf, qf, sc[mt]); }
            }
#pragma unroll
            for (int mt = 0; mt < 4; ++mt) { const int m0 = hv * 64 + mt * 16 + 4 * fq; float v[4];
#pragma unroll
                for (int r = 0; r < 4; ++r) { const int dm = cg - (m0 + r); v[r] = (dm >= 0) ? sc[mt][r] * exp2f((float)dm * lg2) : 0.f; }
                u32x2 w; w.x = pk2(v[0], v[1]); w.y = pk2(v[2], v[3]);
                *(LAS u32x2*)(lds + OFF_SS + ((cb * 16 + fr) * 136 + m0) * 2) = w; }
        }
        __syncthreads();
        f32x4 oi[4], oc[4];
#pragma unroll
        for (int et = 0; et < 4; ++et) { oi[et] = (f32x4){0.f, 0.f, 0.f, 0.f}; oc[et] = (f32x4){0.f, 0.f, 0.f, 0.f}; }
#pragma unroll
        for (int ks = 0; ks < 4; ++ks) {
            const bf16x8 qf = *(const LAS bf16x8*)(lds + OFF_QS + ((cb * 16 + fr) * 136 + 32 * ks + 8 * fq) * 2);
#pragma unroll
            for (int et = 0; et < 4; ++et) { const bf16x8 pf = *(const LAS bf16x8*)(lds + OFF_PT + ((hv * 64 + et * 16 + fr) * 136 + 32 * ks + 8 * fq) * 2); MFMA16(pf, qf, oc[et]); }
            if (ks < nit) {
                const bf16x8 sf = *(const LAS bf16x8*)(lds + OFF_SS + ((cb * 16 + fr) * 136 + 32 * ks + 8 * fq) * 2);
#pragma unroll
                for (int et = 0; et < 4; ++et) { const bf16x8 vf = tr_frag(lds + OFF_VT, 272, 32 * ks, hv * 64 + et * 16, lane); MFMA16(vf, sf, oi[et]); }
            }
        }
        const float xi = exp2f((float)(cg + 1) * lg2);
        float ss = 0.f;
#pragma unroll
        for (int et = 0; et < 4; ++et) { oi[et] = oi[et] + oc[et] * xi; ss += (oi[et].x * oi[et].x + oi[et].y * oi[et].y) + (oi[et].z * oi[et].z + oi[et].w * oi[et].w); }
        ss += __shfl_xor(ss, 16); ss += __shfl_xor(ss, 32);
        if (fq == 0) red[(h * 64 + cb * 16 + fr) * 2 + hv] = ss;
        __syncthreads();
        const float rstd = rsqrtf((red[(h * 64 + cb * 16 + fr) * 2] + red[(h * 64 + cb * 16 + fr) * 2 + 1]) * (1.0f / 128.0f) + EPS);
#pragma unroll
        for (int et = 0; et < 4; ++et) {
            f32x4 o;
            o.x = oi[et].x * rstd * __uint_as_float(gr[et].x << 16); o.y = oi[et].y * rstd * __uint_as_float(gr[et].x & 0xffff0000u);
            o.z = oi[et].z * rstd * __uint_as_float(gr[et].y << 16); o.w = oi[et].w * rstd * __uint_as_float(gr[et].y & 0xffff0000u);
            ss512 += (o.x * o.x + o.y * o.y) + (o.z * o.z + o.w * o.w);
            u32x2 w; w.x = pk2(o.x, o.y); w.y = pk2(o.z, o.w);
            *(u32x2*)(Y + (size_t)(t0 + cb * 16 + fr) * DM + 256 + h * 128 + hv * 64 + et * 16 + 4 * fq) = w;
        }
    }
#undef RET_ISSUE
    ss512 += __shfl_xor(ss512, 16); ss512 += __shfl_xor(ss512, 32);
    LAS float* red5 = red + 512;
    if (fq == 0) red5[(cb * 16 + fr) * 2 + hv] = ss512;
    __syncthreads();
    const float rstd = rsqrtf((red5[(cb * 16 + fr) * 2] + red5[(cb * 16 + fr) * 2 + 1]) * (1.0f / 512.0f) + EPS);
#pragma unroll 1
    for (int h = 0; h < 4; ++h)
#pragma unroll
        for (int et = 0; et < 4; ++et) { u32x2* yp = (u32x2*)(Y + (size_t)(t0 + cb * 16 + fr) * DM + 256 + h * 128 + hv * 64 + et * 16 + 4 * fq); const u32x2 r = *yp;
            u32x2 w; w.x = pk2(__uint_as_float(r.x << 16) * rstd, __uint_as_float(r.x & 0xffff0000u) * rstd); w.y = pk2(__uint_as_float(r.y << 16) * rstd, __uint_as_float(r.y & 0xffff0000u) * rstd);
            *yp = w; }
    __syncthreads();
}

__device__ __forceinline__ void m2_scans(const Args& a, int l, int tid, int G) {
    const int gt = blockIdx.x * NTHR + tid, NGT = G * NTHR;
    for (int i = gt; i < 8 * 16384; i += NGT) {
        const int bh = i >> 14, ed = i & 16383, h = bh & 3;
        const float gC = exp2f(128.0f * ret_lg2(h));
        const float* p = (const float*)(a.ws + WS_KV) + (size_t)bh * 64 * 16384 + ed; bf16* pb = (bf16*)(a.ws + WS_PB) + (size_t)bh * 64 * 16384 + ed;
        float S = 0.f;
        {
            float v[64];
#pragma unroll
            for (int j = 0; j < 64; ++j) v[j] = p[(size_t)j * 16384];
#pragma unroll
            for (int j = 0; j < 64; ++j) { pb[(size_t)j * 16384] = (bf16)(pk2(S, 0.f) & 0xffffu); S = fmaf(gC, S, v[j]); }
        }
    }
    const int rt = NGT - 1 - gt;
    if (rt < 2048) {
        const int p = rt & 63, g = (rt >> 6) & 15, b = rt >> 10;
        const float* tab = (const float*)(a.ws + WS_W + (size_t)l * WL_STRIDE + WL_S5T) + (size_t)g * 36 * 64;
        const float cr = tab[128 + p], ci = tab[192 + p];
        float* E = (float*)(a.ws + WS_S5E);
        float sre = 0.f, sim = 0.f;
        for (int nb = 0; nb < 128; nb += 32) {
            float er[32], ei[32];
#pragma unroll
            for (int j = 0; j < 32; ++j) { const size_t o = ((size_t)((b * 128 + nb + j) * 16 + g) * 2) * 64 + p; er[j] = E[o]; ei[j] = E[o + 64]; }
#pragma unroll
            for (int j = 0; j < 32; ++j) { const size_t o = ((size_t)((b * 128 + nb + j) * 16 + g) * 2) * 64 + p; E[o] = sre; E[o + 64] = sim;
                const float nre = cr * sre - ci * sim + er[j], nim = cr * sim + ci * sre + ei[j]; sre = nre; sim = nim; }
        }
    } else if (rt < 2048 + 512) {
        const int q = rt - 2048, ch = q & 255, b = q >> 8;
        float* AE = (float*)(a.ws + WS_LRUC); float* HE = AE + 2 * 128 * 256;
        float hcar = 0.f;
        for (int nb = 0; nb < 128; nb += 32) {
            float av[32], hv[32];
#pragma unroll
            for (int j = 0; j < 32; ++j) { const size_t o = (size_t)(b * 128 + nb + j) * 256 + ch; av[j] = AE[o]; hv[j] = HE[o]; }
#pragma unroll
            for (int j = 0; j < 32; ++j) { const size_t o = (size_t)(b * 128 + nb + j) * 256 + ch; HE[o] = hcar; hcar = fmaf(av[j], hcar, hv[j]); }
        }
    }
}

__global__ void __launch_bounds__(NTHR, 2) fwd_kernel(Args a) {
    extern __shared__ __attribute__((aligned(16))) unsigned char lds_raw[];
    LAS unsigned char* lds = (LAS unsigned char*)lds_raw;
    cg::grid_group grid = cg::this_grid();
    const int G = gridDim.x;
#define PH_IDS int tid = threadIdx.x; asm volatile("" : "+v"(tid)); const int lane = tid & 63, wave = __builtin_amdgcn_readfirstlane(tid >> 6); (void)lane; (void)wave;
    bf16* XB = (bf16*)(a.ws + WS_XB); bf16* HZ = (bf16*)(a.ws + WS_HZ); bf16* Y = (bf16*)(a.ws + WS_Y); float* SSQ = (float*)(a.ws + WS_SSQ);
    const float* RC = (const float*)(a.ws + WS_ROPE); const float* RS = RC + SEQ * 64;

    volatile LAS unsigned* MISC = (volatile LAS unsigned*)(lds + MISC_OFF);
    if (threadIdx.x < 16) MISC[threadIdx.x] = 0u;
    __syncthreads();
    const XcdBarrier bar = xcd_barrier_post((unsigned*)(a.ws + WS_CTL) + CW_BAR, MISC + 8);
    { PH_IDS p0_prologue(a, lds, tid, lane, wave, G); }
    grid.sync();
#define GRID_BAR() xcd_barrier(bar)

    for (int l = 0; l < NL; ++l) {
        unsigned char* wl = a.ws + WS_W + (size_t)l * WL_STRIDE;
#pragma unroll 1
        for (int f = 0; f < 2; ++f) {
            if (f == 1) {
                { pg8::Gemm g{XB, (const bf16*)(wl + WL_WIN), NTOK, IW, DM}; pg8::StaticOrder S; S.init(NTOK, IW, G, (int)blockIdx.x);
                  EpiWin E{HZ, SSQ, RC, RS, lds + OFF_SSQL};
                  pg8::gemm_phase<EpiWin, pg8::StaticOrder, true, true>(lds, g, S, E); }
                if (G == 256 && blockIdx.x >= 192) tail_convert(a, l + 1, 128 + (int)blockIdx.x - 192, lds);
                GRID_BAR();
                for (int it = blockIdx.x; it < 768; it += G) { PH_IDS
                    const int bx = it & 255, s = it >> 8, xq = bx & 7, jq = bx >> 3;
                    if (it < 256) { const int tile = (G == 256) ? xq * 32 + jq : it; s5_m1(a, l, tile, lds, tid, lane, wave); lru_tile<false>(a, l, tile, lds, tid, lane, wave); }
                    else { const int q = jq + 32 * (s - 1); const int unit = (G == 256) ? (((xq >> 2) * 4 + (q & 3)) * 64 + (xq & 3) * 16 + (q >> 2)) : it - 256; ret_kv(a, unit, lds, tid, lane, wave); }
                }
                GRID_BAR();
                { PH_IDS m2_scans(a, l, tid, G); }
                GRID_BAR();
                for (int it0 = blockIdx.x; it0 < 256; it0 += G) {
                    const int it = (G == 256) ? (it0 & 7) * 32 + (it0 >> 3) : it0;
                    { PH_IDS ret_out(a, it, lds, tid, lane, wave); }
                    { PH_IDS s5_m3(a, l, it, lds, tid, lane, wave); }
                    { PH_IDS lru_tile<true>(a, l, it, lds, tid, lane, wave); }
                }
                GRID_BAR();
                { pg8::Gemm g{Y, (const bf16*)(wl + WL_WOUT), NTOK, DM, DM}; pg8::StaticOrder S; S.init(NTOK, DM, G, (int)blockIdx.x);
                  EpiRes E{XB, SSQ, 1.0f, 1.0f};
                  pg8::gemm_phase<EpiRes, pg8::StaticOrder, true, true>(lds, g, S, E); }
                GRID_BAR();
            }
            { pg8::Gemm g{XB, (const bf16*)(wl + (f ? WL_GU2 : WL_GU1)), NTOK, 2 * FF, DM}; pg8::StaticOrder S; S.init(NTOK, 2 * FF, G, (int)blockIdx.x);
              EpiGU E{HZ, SSQ, lds + OFF_SSQL};
              pg8::gemm_phase<EpiGU, pg8::StaticOrder, true, true>(lds, g, S, E); }
            if (G == 256 && blockIdx.x >= 128) tail_convert(a, l + 1, f * 192 + (int)blockIdx.x - 128, lds);
            GRID_BAR();
            { pg8::Gemm g{HZ, (const bf16*)(wl + (f ? WL_D2 : WL_D1)), NTOK, DM, FF}; pg8::StaticOrder S; S.init(NTOK, DM, G, (int)blockIdx.x);
              EpiRes E{XB, SSQ, 0.5f, 2.0f};
              pg8::gemm_phase<EpiRes, pg8::StaticOrder, true, true>(lds, g, S, E); }
            GRID_BAR();
        }
    }
    { PH_IDS
        const int gw = blockIdx.x * NWAVE + wave, NGW = G * NWAVE; const float* fn = a.in[32];
        for (int m = gw; m < NTOK; m += NGW) {
            const u32x2* xr = (const u32x2*)(XB + (size_t)m * DM) + lane; f32x4* orow = (f32x4*)(a.out + (size_t)m * DM) + lane; f32x4 v[4]; float s = 0.f;
#pragma unroll
            for (int j = 0; j < 4; ++j) { const u32x2 r = xr[64 * j]; v[j] = (f32x4){__uint_as_float(r.x << 16), __uint_as_float(r.x & 0xffff0000u), __uint_as_float(r.y << 16), __uint_as_float(r.y & 0xffff0000u)};
                s += (v[j].x * v[j].x + v[j].y * v[j].y) + (v[j].z * v[j].z + v[j].w * v[j].w); }
            const float rstd = rsqrtf(wave_sum(s) * (1.0f / DM) + EPS);
#pragma unroll
            for (int j = 0; j < 4; ++j) { const f32x4 gn = *((const f32x4*)fn + lane + 64 * j); orow[64 * j] = v[j] * rstd * gn; }
        }
    }
}

extern "C" void kernel_launch(void* const* d_in, const int* in_sizes, int n_in, void* d_out, int out_size, void* d_ws, size_t ws_size, hipStream_t stream) {
    static int grid = 0;
    if (grid == 0) {
        if (n_in != 33 || in_sizes[0] != NTOK * DM || out_size != NTOK * DM || ws_size < WS_END) { fprintf(stderr, "kernel_launch: unexpected shapes (n_in %d, in0 %d, out %d, ws %zu < %zu)\n", n_in, n_in > 0 ? in_sizes[0] : -1, out_size, ws_size, (size_t)WS_END); grid = -1; return; }
        int dev = 0, cus = 0, per_cu = 0;
        hipGetDevice(&dev); hipDeviceGetAttribute(&cus, hipDeviceAttributeMultiprocessorCount, dev);
        if (hipFuncSetAttribute((const void*)fwd_kernel, hipFuncAttributeMaxDynamicSharedMemorySize, LDS_BYTES) != hipSuccess) { fprintf(stderr, "kernel_launch: hipFuncSetAttribute failed\n"); grid = -1; return; }
        if (hipOccupancyMaxActiveBlocksPerMultiprocessor(&per_cu, (const void*)fwd_kernel, NTHR, LDS_BYTES) != hipSuccess || per_cu < 1) { fprintf(stderr, "kernel_launch: occupancy query says %d\n", per_cu); per_cu = 1; }
        (void)hipGetLastError();
        grid = cus * 1;
    }
    if (grid < 0) return;
    Args a{};
    for (int i = 0; i < 33; ++i) a.in[i] = (const float*)d_in[i];
    a.out = (float*)d_out; a.ws = (unsigned char*)d_ws;
    if (hipMemsetAsync((char*)d_ws + WS_CTL, 0, 65536, stream) != hipSuccess) { fprintf(stderr, "kernel_launch: memset failed\n"); return; }
    void* args[] = {&a};
    hipError_t e = hipLaunchCooperativeKernel((const void*)fwd_kernel, dim3(grid), dim3(NTHR), args, LDS_BYTES, stream);
    if (e != hipSuccess) fprintf(stderr, "kernel_launch: cooperative launch failed: %s (grid %d)\n", hipGetErrorString(e), grid);
}
```

```cpp
#include <hip/hip_runtime.h>
#include <hip/hip_cooperative_groups.h>
#include <cstdio>
#include <cstdint>
namespace cg = cooperative_groups;
namespace pg8 {
#define PG8_LAS __attribute__((address_space(3)))
typedef unsigned short bf16_t;
typedef short bf16x8 __attribute__((ext_vector_type(8)));
typedef float f32x4 __attribute__((ext_vector_type(4)));
typedef unsigned u32x4 __attribute__((ext_vector_type(4)));
constexpr int BM = 256, BK = 64, HALF = 128, HTB = HALF * BK * 2  , STAGE_BYTES = 8 * HTB, NXCD = 8, WGM = 4;

__host__ __device__ __forceinline__ int lds_byte(int r, int c) { const int st = (r >> 4) * 2 + (c >> 5), rr = r & 15, cc = c & 31, ob = rr * 64 + cc * 2; return st * 1024 + (ob ^ (((ob >> 9) & 1) << 5)); }
__host__ __device__ __forceinline__ void stage_rc(int b, int& R, int& C) { const int st = b / 1024, sb = b % 1024, swz = sb ^ (((sb >> 9) & 1) << 5); R = (st >> 1) * 16 + swz / 64; C = (st & 1) * 32 + (swz % 64) / 2; }
__host__ __device__ __forceinline__ int perm32(int rho) { const int n = rho >> 4, i = rho & 15; return 8 * (i >> 2) + 4 * n + (i & 3); }

struct Unit { int pm, pn; };
struct Gemm { const bf16_t* A; const bf16_t* Bt; int M, N, K; };

struct StaticOrder {
    int nM, nN, nwg, G, c;
    __host__ __device__ void init(int M, int N, int G_, int c_) { nM = M / BM; nN = N / BM; nwg = nM * nN; G = G_; c = c_; }
    __host__ __device__ bool next(int i, Unit& u) const {
        const long L = (long)i * G + c; if (L >= nwg) return false;
        int wgid = (int)L; { const int q = nwg / NXCD, r = nwg % NXCD, xcd = wgid % NXCD, off = wgid / NXCD; wgid = (xcd < r ? xcd * (q + 1) : r * (q + 1) + (xcd - r) * q) + off; }
        const int nig = WGM * nN, gid = wgid / nig, fm = gid * WGM, gsz = (nM - fm) < WGM ? (nM - fm) : WGM;
        u.pm = fm + ((wgid % nig) % gsz); u.pn = (wgid % nig) / gsz; return true;
    }
    __device__ __forceinline__ void a_ready(const Unit&) const {}
    __device__ __forceinline__ void done(const Unit&) const {}
};

__device__ __forceinline__ unsigned cvt_pk_bf16(float lo, float hi) { unsigned r; asm volatile("v_cvt_pk_bf16_f32 %0, %1, %2" : "=v"(r) : "v"(lo), "v"(hi)); return r; }
template <class Epi, class Sched, bool ALIGN_EPI = false, bool SP2 = false>
__device__ __forceinline__ void gemm_phase(PG8_LAS unsigned char* lds, const Gemm g, const Sched& S, const Epi& E) {
    int tid_ = threadIdx.x; asm volatile("" : "+v"(tid_)); const int tid = tid_, wid = __builtin_amdgcn_readfirstlane(tid >> 6), lane = tid & 63, wr = wid >> 2, wc = wid & 3, fr = lane & 15, fq = lane >> 4;
    const int K = g.K, nt = K / BK;
    unsigned voffA[2], voffB[2];
#pragma unroll
    for (int i = 0; i < 2; ++i) { int R, C; stage_rc(tid * 16 + i * 8192, R, C); const int Rb = Epi::PERM ? ((R & ~31) + perm32(R & 31)) : R;
        voffA[i] = (unsigned)(R * K + C) * 2u; voffB[i] = (unsigned)(Rb * K + C) * 2u; }
    const size_t kstep = (size_t)(BK * 2);
    const size_t hstep = (size_t)HALF * K * 2;
    const size_t tstep = 2 * hstep;
    const unsigned ldsw = (unsigned)wid * 1024u;
    const int aoff = lds_byte(wr * 64 + fr, fq * 8), boff = lds_byte(wc * 32 + fr, fq * 8);
#define PG8_SA(b, h) (((b) * 2 + (h)) * HTB)
#define PG8_SB(b, h) ((4 + (b) * 2 + (h)) * HTB)
#define PG8_STAGE(bufoff, gbase, voff) do { _Pragma("unroll") for (int _i = 0; _i < 2; ++_i) \
        __builtin_amdgcn_global_load_lds((const unsigned*)((const char*)(gbase) + (voff)[_i]), (PG8_LAS unsigned*)(lds + (bufoff) + ldsw + _i * 8192), 16, 0, 0); } while (0)
#define PG8_LDA(dst, b, h) do { _Pragma("unroll") for (int m = 0; m < 4; ++m) _Pragma("unroll") for (int k = 0; k < 2; ++k) dst[m][k] = *(const PG8_LAS bf16x8*)(lds + PG8_SA(b, h) + aoff + m * 2048 + k * 1024); } while (0)
#define PG8_LDB(dst, b, h) do { _Pragma("unroll") for (int n = 0; n < 2; ++n) _Pragma("unroll") for (int k = 0; k < 2; ++k) dst[n][k] = *(const PG8_LAS bf16x8*)(lds + PG8_SB(b, h) + boff + n * 2048 + k * 1024); } while (0)
#define PG8_MMA(ai, bj, At, Bt) do { __builtin_amdgcn_s_setprio(1); _Pragma("unroll") for (int m = 0; m < 4; ++m) _Pragma("unroll") for (int n = 0; n < 2; ++n) _Pragma("unroll") for (int k = 0; k < 2; ++k) \
        acc[ai][bj][m][n] = __builtin_amdgcn_mfma_f32_16x16x32_bf16(Bt[n][k], At[m][k], acc[ai][bj][m][n], 0, 0, 0); __builtin_amdgcn_s_setprio(0); } while (0)
#define PG8_WAIT_V(n) asm volatile("s_waitcnt vmcnt(" #n ")" ::: "memory")
#define PG8_WAIT_L(n) asm volatile("s_waitcnt lgkmcnt(" #n ")" ::: "memory")
#define PG8_BAR __builtin_amdgcn_s_barrier()
#define PG8_SCHED __builtin_amdgcn_sched_barrier(0)
    Unit cur, nxt; int ui = 0;
    if (!S.next(0, cur)) return;
    f32x4 acc[2][2][4][2];
    typename Epi::Pre pre0 = E.issue(cur, wr, wc, fr, fq);
    bf16x8 At[4][2], B0[2][2], B1[2][2];
    const char* cA = (const char*)g.A + (size_t)cur.pm * tstep; const char* cB = (const char*)g.Bt + (size_t)cur.pn * tstep;
    S.a_ready(cur);
    if constexpr (SP2) {
        PG8_STAGE(PG8_SB(0, 0), cB, voffB); PG8_STAGE(PG8_SB(0, 1), cB + hstep, voffB); PG8_STAGE(PG8_SA(0, 0), cA, voffA); PG8_STAGE(PG8_SA(0, 1), cA + hstep, voffA);
        if (wr == 1) PG8_BAR;
        PG8_WAIT_V(2); PG8_BAR;
        PG8_STAGE(PG8_SB(1, 0), cB + kstep, voffB); PG8_STAGE(PG8_SA(1, 0), cA + kstep, voffA); PG8_STAGE(PG8_SB(1, 1), cB + hstep + kstep, voffB);
        PG8_WAIT_V(6); PG8_BAR;
    } else {
        PG8_STAGE(PG8_SB(0, 0), cB, voffB); PG8_STAGE(PG8_SA(0, 0), cA, voffA); PG8_STAGE(PG8_SB(0, 1), cB + hstep, voffB); PG8_STAGE(PG8_SA(0, 1), cA + hstep, voffA);
        if (wr == 1) PG8_BAR;
        PG8_WAIT_V(4); PG8_BAR;
        PG8_STAGE(PG8_SB(1, 0), cB + kstep, voffB); PG8_STAGE(PG8_SA(1, 0), cA + kstep, voffA); PG8_STAGE(PG8_SB(1, 1), cB + hstep + kstep, voffB);
        PG8_WAIT_V(6); PG8_BAR;
    }
    PG8_SCHED; E.finish(acc, pre0); PG8_SCHED;
    for (;;) {
        const bool has_next = S.next(ui + 1, nxt);
        const char* nA = has_next ? (const char*)g.A + (size_t)nxt.pm * tstep : cA; const char* nB = has_next ? (const char*)g.Bt + (size_t)nxt.pn * tstep : cB;
        for (int t = 0; t < nt; t += 2) {
            const bool last = (t == nt - 2);
            const char* a1 = cA + (size_t)(t + 1) * kstep;
            const char* a2 = last ? nA : cA + (size_t)(t + 2) * kstep; const char* b2 = last ? nB : cB + (size_t)(t + 2) * kstep;
            const char* a3 = a2 + kstep; const char* b3 = b2 + kstep;
            if (last && has_next) S.a_ready(nxt);
            if (last) E.pre(cur, wid, lane);
            if constexpr (SP2) {
            PG8_LDB(B0, 0, 0); PG8_LDB(B1, 0, 1); PG8_SCHED; PG8_LDA(At, 0, 0); PG8_STAGE(PG8_SA(1, 1), a1 + hstep, voffA);
            PG8_WAIT_V(8); PG8_WAIT_L(0); PG8_BAR; PG8_MMA(0, 0, At, B0); PG8_MMA(0, 1, At, B1); PG8_BAR; PG8_SCHED;
            PG8_LDA(At, 0, 1); PG8_STAGE(PG8_SB(0, 0), b2, voffB); PG8_STAGE(PG8_SB(0, 1), b2 + hstep, voffB); PG8_STAGE(PG8_SA(0, 0), a2, voffA);
            PG8_WAIT_V(8); PG8_WAIT_L(0); PG8_BAR; PG8_MMA(1, 0, At, B0); PG8_MMA(1, 1, At, B1); PG8_BAR; PG8_SCHED;
            PG8_LDB(B0, 1, 0); PG8_LDB(B1, 1, 1); PG8_SCHED; PG8_LDA(At, 1, 0); PG8_STAGE(PG8_SA(0, 1), a2 + hstep, voffA);
            PG8_WAIT_V(8); PG8_WAIT_L(0); PG8_BAR; PG8_MMA(0, 0, At, B0); PG8_MMA(0, 1, At, B1); PG8_BAR; PG8_SCHED;
            PG8_LDA(At, 1, 1); PG8_STAGE(PG8_SB(1, 0), b3, voffB); PG8_STAGE(PG8_SB(1, 1), b3 + hstep, voffB); PG8_STAGE(PG8_SA(1, 0), a3, voffA);
            PG8_WAIT_V(8); PG8_WAIT_L(0); PG8_BAR; PG8_MMA(1, 0, At, B0); PG8_MMA(1, 1, At, B1); PG8_BAR; PG8_SCHED;
            } else {
            PG8_LDB(B0, 0, 0); PG8_SCHED; PG8_LDA(At, 0, 0); PG8_STAGE(PG8_SA(1, 1), a1 + hstep, voffA);
            PG8_WAIT_L(8); PG8_BAR; PG8_WAIT_L(0); PG8_MMA(0, 0, At, B0); PG8_BAR; PG8_SCHED;
            PG8_LDB(B1, 0, 1); PG8_STAGE(PG8_SB(0, 0), b2, voffB);
            PG8_BAR; PG8_WAIT_L(0); PG8_MMA(0, 1, At, B1); PG8_BAR;
            PG8_LDA(At, 0, 1); PG8_STAGE(PG8_SA(0, 0), a2, voffA);
            PG8_BAR; PG8_WAIT_L(0); PG8_MMA(1, 0, At, B0); PG8_BAR; PG8_SCHED;
            PG8_STAGE(PG8_SB(0, 1), b2 + hstep, voffB);
            PG8_WAIT_V(6); PG8_BAR; PG8_MMA(1, 1, At, B1); PG8_BAR;
            PG8_LDB(B0, 1, 0); PG8_SCHED; PG8_LDA(At, 1, 0); PG8_STAGE(PG8_SA(0, 1), a2 + hstep, voffA);
            PG8_WAIT_L(8); PG8_BAR; PG8_WAIT_L(0); PG8_MMA(0, 0, At, B0); PG8_BAR; PG8_SCHED;
            PG8_LDB(B1, 1, 1); PG8_STAGE(PG8_SB(1, 0), b3, voffB);
            PG8_BAR; PG8_WAIT_L(0); PG8_MMA(0, 1, At, B1); PG8_BAR;
            PG8_LDA(At, 1, 1); PG8_STAGE(PG8_SA(1, 0), a3, voffA);
            PG8_BAR; PG8_WAIT_L(0); PG8_MMA(1, 0, At, B0); PG8_BAR; PG8_SCHED;
            PG8_STAGE(PG8_SB(1, 1), b3 + hstep, voffB);
            PG8_WAIT_V(6); PG8_BAR; PG8_MMA(1, 1, At, B1); PG8_BAR;
            }
        }
        if constexpr (ALIGN_EPI) { if (wr == 0) PG8_BAR; }
        if constexpr (!Epi::AFTER_DRAIN) { E(acc, cur, wr, wc, fr, fq); S.done(cur); }
        if (!has_next) break;
        { typename Epi::Pre pren = E.issue(nxt, wr, wc, fr, fq); E.finish(acc, pren); }
        cur = nxt; cA = nA; cB = nB; ++ui;
        if constexpr (ALIGN_EPI) { if (wr == 1) PG8_BAR; }
    }
    PG8_WAIT_V(0);
    if constexpr (!ALIGN_EPI) { if (wr == 0) PG8_BAR; }
    PG8_BAR;
    if constexpr (Epi::AFTER_DRAIN) { E.fused(acc, cur, wr, wc, fr, fq, lds, wid, lane); S.done(cur); }
#undef PG8_SA
#undef PG8_SB
#undef PG8_STAGE
#undef PG8_LDA
#undef PG8_LDB
#undef PG8_MMA
#undef PG8_WAIT_V
#undef PG8_WAIT_L
#undef PG8_BAR
#undef PG8_SCHED
}
}

#define LAS __attribute__((address_space(3)))
typedef unsigned short bf16;
typedef float f32x4 __attribute__((ext_vector_type(4)));
typedef float f32x2 __attribute__((ext_vector_type(2)));
typedef short bf16x8 __attribute__((ext_vector_type(8)));
typedef unsigned u32x4 __attribute__((ext_vector_type(4)));
typedef unsigned u32x2 __attribute__((ext_vector_type(2)));

constexpr int NTOK = 16384, SEQ = 8192, DM = 1024, FF = 2816, IW = 2816, NL = 4;
constexpr float EPS = 1e-6f;
constexpr int NTHR = 512, NWAVE = 8;
constexpr int LDS_BYTES = 155648;
constexpr int OFF_SSQL = 131072;

constexpr size_t MiB = 1u << 20;
constexpr size_t WS_CTL = 0;
constexpr size_t WS_ROPE = 1 * MiB;
constexpr size_t WS_SSQ = 5 * MiB;
constexpr size_t WS_S5E = 6 * MiB;
constexpr size_t WS_LRUC = 8 * MiB;
constexpr size_t WS_TAB = 9 * MiB;
constexpr size_t WS_W = 10 * MiB;
constexpr size_t WL_STRIDE = 43 * MiB;
constexpr size_t WL_GU1 = 0, WL_D1 = 11534336, WL_WIN = WL_D1 + 5767168, WL_WOUT = WL_WIN + 5767168, WL_GU2 = WL_WOUT + 2097152,
                 WL_D2 = WL_GU2 + 11534336, WL_GLU = WL_D2 + 5767168, WL_WA = WL_GLU + 131072, WL_WX = WL_WA + 32768, WL_CM = WL_WX + 32768,
                 WL_S5T = WL_CM + 65536, WL_BB = WL_S5T + 147456, WL_END = WL_BB + 65536;
static_assert(WL_END <= WL_STRIDE, "weights per layer");
constexpr size_t WS_XB = 182 * MiB;
constexpr size_t WS_HZ = 214 * MiB;
constexpr size_t WS_Y = 302 * MiB;
constexpr size_t WS_KV = 334 * MiB;
constexpr size_t WS_PB = 366 * MiB;
constexpr size_t WS_END = 382 * MiB;

struct Args { const float* in[33]; float* out; unsigned char* ws; };

#define XB_TMO      128
#define XB_XCNT(j)  (256  + 64 * (j))
#define XB_XSUB(j)  (1280 + 64 * (j))
#define XB_XGEN(j)  (2304 + 64 * (j))
#define XB_TOP      3328
#define XB_TOPGEN   3392
#define XCD_BAR_WORDS 3456
#define XB_SPIN_CAP (1u << 18)

__device__ __forceinline__ unsigned xb_ld(unsigned* p)              { return __hip_atomic_load(p, __ATOMIC_RELAXED, __HIP_MEMORY_SCOPE_AGENT); }
__device__ __forceinline__ unsigned xb_add(unsigned* p, unsigned v) { return __hip_atomic_fetch_add(p, v, __ATOMIC_RELAXED, __HIP_MEMORY_SCOPE_AGENT); }
__device__ __forceinline__ unsigned xb_xcc_id() { return (unsigned)__builtin_amdgcn_s_getreg((3 << 11) | 20) & 0xFu; }
#define XB_SPIN(cond, bar) do { unsigned _sp = 0; while (cond) { __builtin_amdgcn_s_sleep(1); \
    if ((++_sp & 255u) == 0u) { if (xb_ld(&(bar)[XB_TMO])) break; if (_sp > XB_SPIN_CAP) { atomicAdd(&(bar)[XB_TMO], 1u); break; } } } } while (0)

struct XcdBarrier {
    unsigned* bar; unsigned x;
    volatile LAS unsigned* st;
};

__device__ __forceinline__ XcdBarrier xcd_barrier_post(unsigned* bar, volatile LAS unsigned* st) {
    XcdBarrier b; b.bar = bar; b.x = xb_xcc_id(); b.st = st;
    if (threadIdx.x == 0) (void)xb_add(&bar[XB_XCNT(b.x)], 1u);
    return b;
}
__device__ __forceinline__ void xcd_barrier_complete(unsigned* bar, unsigned x, unsigned& nloc, unsigned& nx) {
    const unsigned G = gridDim.x * gridDim.y * gridDim.z;
    unsigned sum, cnt, mine, sp = 0u;
    for (;;) {
        sum = 0u; cnt = 0u; mine = 0u;
#pragma unroll
        for (unsigned j = 0; j < 16; ++j) { const unsigned c = xb_ld(&bar[XB_XCNT(j)]); sum += c; cnt += (c > 0u) ? 1u : 0u; mine = (j == x) ? c : mine; }
        if (sum == G) break;
        __builtin_amdgcn_s_sleep(1);
        if ((++sp & 255u) == 0u) { if (xb_ld(&bar[XB_TMO])) break; if (sp > XB_SPIN_CAP) { atomicAdd(&bar[XB_TMO], 1u); break; } }
    }
    nloc = mine > 0u ? mine : 1u; nx = cnt > 0u ? cnt : 1u;
}

__device__ __forceinline__ void xcd_barrier(const XcdBarrier& b) {
    asm volatile("s_waitcnt vmcnt(0)" ::: "memory");
    __syncthreads();
    if (threadIdx.x == 0) {
        unsigned* bar = b.bar;
        __builtin_amdgcn_s_waitcnt(0);
        unsigned nloc = b.st[0], nx = b.st[1];
        if (nloc == 0u) { xcd_barrier_complete(bar, b.x, nloc, nx); b.st[0] = nloc; b.st[1] = nx; }
        const unsigned old = xb_add(&bar[XB_XSUB(b.x)], 1u);
        const unsigned gen = old / nloc;
        if (old + 1u == (gen + 1u) * nloc) {
            __builtin_amdgcn_fence(__ATOMIC_RELEASE, "agent");
            asm volatile("s_waitcnt vmcnt(0)" ::: "memory");
            const unsigned og = xb_add(&bar[XB_TOP], 1u);
            const unsigned tg = og / nx;
            if (og + 1u == (tg + 1u) * nx) xb_add(&bar[XB_TOPGEN], 1u);
            else XB_SPIN(xb_ld(&bar[XB_TOPGEN]) == tg, bar);
            __builtin_amdgcn_fence(__ATOMIC_ACQUIRE, "agent");
            xb_add(&bar[XB_XGEN(b.x)], 1u);
            asm volatile("s_waitcnt vmcnt(0)" ::: "memory");
        } else {
            XB_SPIN(xb_ld(&bar[XB_XGEN(b.x)]) == gen, bar);
            __builtin_amdgcn_fence(__ATOMIC_ACQUIRE, "agent");
            asm volatile("s_waitcnt vmcnt(0)" ::: "memory");
        }
    }
    __syncthreads();
}

constexpr int MISC_OFF = LDS_BYTES - 64;
constexpr int CW_BAR = 4096;

__device__ __forceinline__ float bf2f(unsigned v) { return __uint_as_float(v << 16); }
__device__ __forceinline__ unsigned pk2(float lo, float hi) { return pg8::cvt_pk_bf16(lo, hi); }
__device__ __forceinline__ float sigmoidf_(float x) { return __builtin_amdgcn_rcpf(1.0f + __expf(-x)); }
__device__ __forceinline__ float siluf_(float x) { return x * sigmoidf_(x); }
__device__ __forceinline__ float geluf_(float x) { const float z = 1.5957691216057308f * (x + 0.044715f * x * x * x); return x * sigmoidf_(z); }
__device__ __forceinline__ void lds_wait() { asm volatile("s_waitcnt lgkmcnt(0)" ::: "memory"); }
__device__ __forceinline__ void unpack8(u32x4 v, float* f) {
    f[0] = __uint_as_float(v.x << 16); f[1] = __uint_as_float(v.x & 0xffff0000u); f[2] = __uint_as_float(v.y << 16); f[3] = __uint_as_float(v.y & 0xffff0000u);
    f[4] = __uint_as_float(v.z << 16); f[5] = __uint_as_float(v.z & 0xffff0000u); f[6] = __uint_as_float(v.w << 16); f[7] = __uint_as_float(v.w & 0xffff0000u);
}
__device__ __forceinline__ float row_rstd(const float* ssq, int row) {
    const f32x4* p = (const f32x4*)(ssq + (size_t)row * 16);
    const f32x4 a = p[0], b = p[1], c = p[2], d = p[3];
    const float s = ((a.x + a.y) + (a.z + a.w)) + ((b.x + b.y) + (b.z + b.w)) + ((c.x + c.y) + (c.z + c.w)) + ((d.x + d.y) + (d.z + d.w));
    return rsqrtf(s * (1.0f / DM) + EPS);
}
__device__ __forceinline__ void rows_rstd(LAS unsigned char* sl, int rl0, int fq, float (&rs)[8]) {
    f32x4 v[8];
#pragma unroll
    for (int i = 0; i < 8; ++i) v[i] = *(const LAS f32x4*)(sl + (rl0 + (i >> 2) * 128 + (i & 3) * 16) * 64 + fq * 16);
#pragma unroll
    for (int i = 0; i < 8; ++i) { float s = (v[i].x + v[i].y) + (v[i].z + v[i].w); s += __shfl_xor(s, 16); s += __shfl_xor(s, 32); rs[i] = rsqrtf(s * (1.0f / DM) + EPS); }
}
#define MFMA16(X, Y, ACC) ACC = __builtin_amdgcn_mfma_f32_16x16x32_bf16(X, Y, ACC, 0, 0, 0)

struct EpiGU {
    static constexpr bool PERM = true, AFTER_DRAIN = false;
    bf16* H; const float* ssq;
    struct Pre {};
    __device__ __forceinline__ Pre issue(const pg8::Unit&, int, int, int, int) const { return Pre{}; }
    __device__ __forceinline__ void finish(f32x4 (&acc)[2][2][4][2], const Pre&) const {
#pragma unroll
        for (int a = 0; a < 2; ++a)
#pragma unroll
            for (int b = 0; b < 2; ++b)
#pragma unroll
                for (int m = 0; m < 4; ++m)
#pragma unroll
                    for (int n = 0; n < 2; ++n) acc[a][b][m][n] = (f32x4){0.f, 0.f, 0.f, 0.f};
    }
    LAS unsigned char* sl;
    __device__ __forceinline__ void pre(const pg8::Unit& u, int wid, int lane) const {
#pragma unroll
        for (int i = 0; i < 2; ++i) __builtin_amdgcn_global_load_lds((const unsigned*)(ssq + (size_t)(u.pm * 256 + wid * 32 + i * 16 + (lane >> 2)) * 16 + (lane & 3) * 4), (LAS unsigned*)(sl + (wid * 32 + i * 16) * 64), 16, 0, 0);
    }
    __device__ __forceinline__ void operator()(const f32x4 (&acc)[2][2][4][2], const pg8::Unit& u, int wr, int wc, int fr, int fq) const {
        const int row0 = u.pm * 256 + wr * 64 + fr, col0 = u.pn * 128 + wc * 32 + 8 * fq;
        float rs[8]; rows_rstd(sl, wr * 64 + fr, fq, rs);
#pragma unroll
        for (int ai = 0; ai < 2; ++ai)
#pragma unroll
            for (int m = 0; m < 4; ++m) {
                const int row = row0 + ai * 128 + m * 16; const float r = rs[ai * 4 + m];
                float h[8];
#pragma unroll
                for (int n = 0; n < 2; ++n)
#pragma unroll
                    for (int j = 0; j < 4; ++j) { const float g = acc[ai][0][m][n][j] * r, up = acc[ai][1][m][n][j] * r; h[n * 4 + j] = siluf_(g) * up; }
                u32x4 w; w.x = pk2(h[0], h[1]); w.y = pk2(h[2], h[3]); w.z = pk2(h[4], h[5]); w.w = pk2(h[6], h[7]);
                *(u32x4*)(H + (size_t)row * FF + col0) = w;
            }
    }
};
struct EpiRes {
    static constexpr bool PERM = true, AFTER_DRAIN = false;
    bf16* XB; float* ssq; float alpha, inv_alpha;
    struct Pre { u32x4 v[2][4][2]; };
    __device__ __forceinline__ void pre(const pg8::Unit&, int, int) const {}
    __device__ __forceinline__ Pre issue(const pg8::Unit& u, int wr, int wc, int fr, int fq) const {
        Pre p; const int row0 = u.pm * 256 + wr * 64 + fr, colb = u.pn * 256 + wc * 32 + 8 * fq;
#pragma unroll
        for (int ai = 0; ai < 2; ++ai)
#pragma unroll
            for (int m = 0; m < 4; ++m)
#pragma unroll
                for (int bj = 0; bj < 2; ++bj) p.v[ai][m][bj] = *(const u32x4*)(XB + (size_t)(row0 + ai * 128 + m * 16) * DM + colb + bj * 128);
        return p;
    }
    __device__ __forceinline__ void finish(f32x4 (&acc)[2][2][4][2], const Pre& p) const {
#pragma unroll
        for (int ai = 0; ai < 2; ++ai)
#pragma unroll
            for (int m = 0; m < 4; ++m)
#pragma unroll
                for (int bj = 0; bj < 2; ++bj) { float f[8]; unpack8(p.v[ai][m][bj], f);
                    acc[ai][bj][m][0] = (f32x4){f[0], f[1], f[2], f[3]} * inv_alpha; acc[ai][bj][m][1] = (f32x4){f[4], f[5], f[6], f[7]} * inv_alpha; }
    }
    __device__ __forceinline__ void operator()(const f32x4 (&acc)[2][2][4][2], const pg8::Unit& u, int wr, int wc, int fr, int fq) const {
        const int row0 = u.pm * 256 + wr * 64 + fr, colb = u.pn * 256 + wc * 32 + 8 * fq;
#pragma unroll
        for (int ai = 0; ai < 2; ++ai)
#pragma unroll
            for (int m = 0; m < 4; ++m) {
                const int row = row0 + ai * 128 + m * 16;
                float ss = 0.f;
#pragma unroll
                for (int bj = 0; bj < 2; ++bj) {
                    const f32x4 x0 = acc[ai][bj][m][0] * alpha, x1 = acc[ai][bj][m][1] * alpha;
                    u32x4 w; w.x = pk2(x0.x, x0.y); w.y = pk2(x0.z, x0.w); w.z = pk2(x1.x, x1.y); w.w = pk2(x1.z, x1.w);
                    *(u32x4*)(XB + (size_t)row * DM + colb + bj * 128) = w;
                    ss += (x0.x * x0.x + x0.y * x0.y) + (x0.z * x0.z + x0.w * x0.w) + (x1.x * x1.x + x1.y * x1.y) + (x1.z * x1.z + x1.w * x1.w);
                }
                ss += __shfl_xor(ss, 16); ss += __shfl_xor(ss, 32);
                if (fq == 0) ssq[(size_t)row * 16 + u.pn * 4 + wc] = ss;
            }
    }
};
struct EpiWin {
    static constexpr bool PERM = true, AFTER_DRAIN = false;
    bf16* Z; const float* ssq; const float* rcos; const float* rsin;
    struct Pre {};
    __device__ __forceinline__ Pre issue(const pg8::Unit&, int, int, int, int) const { return Pre{}; }
    __device__ __forceinline__ void finish(f32x4 (&acc)[2][2][4][2], const Pre&) const {
#pragma unroll
        for (int a = 0; a < 2; ++a)
#pragma unroll
            for (int b = 0; b < 2; ++b)
#pragma unroll
                for (int m = 0; m < 4; ++m)
#pragma unroll
                    for (int n = 0; n < 2; ++n) acc[a][b][m][n] = (f32x4){0.f, 0.f, 0.f, 0.f};
    }
    LAS unsigned char* sl;
    __device__ __forceinline__ void pre(const pg8::Unit& u, int wid, int lane) const {
#pragma unroll
        for (int i = 0; i < 2; ++i) __builtin_amdgcn_global_load_lds((const unsigned*)(ssq + (size_t)(u.pm * 256 + wid * 32 + i * 16 + (lane >> 2)) * 16 + (lane & 3) * 4), (LAS unsigned*)(sl + (wid * 32 + i * 16) * 64), 16, 0, 0);
    }
    __device__ __forceinline__ void operator()(const f32x4 (&acc)[2][2][4][2], const pg8::Unit& u, int wr, int wc, int fr, int fq) const {
        const int row0 = u.pm * 256 + wr * 64 + fr, pn = u.pn;
        float rs[8]; rows_rstd(sl, wr * 64 + fr, fq, rs);
        if (pn >= 1 && pn <= 4) {
            const float qs = (pn <= 2) ? 0.08838834764831845f : 1.0f;
            const int dd0 = 32 * (wc & 1) + 8 * fq, hh = wc >> 1;
#pragma unroll
            for (int ab = 0; ab < 4; ++ab) { const int ai = ab >> 1, mb = (ab & 1) * 2;
                f32x4 cs[4][4];
#pragma unroll
                for (int m = mb; m < mb + 2; ++m) { const int pos = (row0 + ai * 128 + m * 16) & (SEQ - 1); const float* cp = rcos + pos * 64 + dd0; const float* sp = rsin + pos * 64 + dd0;
                    cs[m][0] = *(const f32x4*)cp; cs[m][1] = *(const f32x4*)(cp + 4); cs[m][2] = *(const f32x4*)sp; cs[m][3] = *(const f32x4*)(sp + 4); }
#pragma unroll
                for (int m = mb; m < mb + 2; ++m) {
                    const int row = row0 + ai * 128 + m * 16; const float r = rs[ai * 4 + m] * qs;
                    const f32x4 c0 = cs[m][0], c1 = cs[m][1], s0 = cs[m][2], s1 = cs[m][3];
                    const f32x4 ta = acc[ai][0][m][0] * r, tb = acc[ai][0][m][1] * r, ua = acc[ai][1][m][0] * r, ub = acc[ai][1][m][1] * r;
                    const f32x4 o1a = ta * c0 - ua * s0, o1b = tb * c1 - ub * s1, o2a = ta * s0 + ua * c0, o2b = tb * s1 + ub * c1;
                    bf16* zp = Z + (size_t)row * IW + pn * 256 + hh * 128 + dd0;
                    u32x4 w1, w2;
                    w1.x = pk2(o1a.x, o1a.y); w1.y = pk2(o1a.z, o1a.w); w1.z = pk2(o1b.x, o1b.y); w1.w = pk2(o1b.z, o1b.w);
                    w2.x = pk2(o2a.x, o2a.y); w2.y = pk2(o2a.z, o2a.w); w2.z = pk2(o2b.x, o2b.y); w2.w = pk2(o2b.z, o2b.w);
                    *(u32x4*)zp = w1; *(u32x4*)(zp + 64) = w2;
                }
                asm volatile("" ::: "memory");
            }
        } else {
            const int act = (pn == 7 || pn == 8) ? 1 : (pn == 10 ? 2 : 0);
#pragma unroll
            for (int ai = 0; ai < 2; ++ai)
#pragma unroll
                for (int m = 0; m < 4; ++m) {
                    const int row = row0 + ai * 128 + m * 16; const float r = rs[ai * 4 + m];
#pragma unroll
                    for (int bj = 0; bj < 2; ++bj) {
                        float v[8];
#pragma unroll
                        for (int n = 0; n < 2; ++n)
#pragma unroll
                            for (int j = 0; j < 4; ++j) { float t = acc[ai][bj][m][n][j] * r; if (act == 1) t = siluf_(t); else if (act == 2) t = geluf_(t); v[n * 4 + j] = t; }
                        u32x4 w; w.x = pk2(v[0], v[1]); w.y = pk2(v[2], v[3]); w.z = pk2(v[4], v[5]); w.w = pk2(v[6], v[7]);
                        *(u32x4*)(Z + (size_t)row * IW + pn * 256 + bj * 128 + wc * 32 + 8 * fq) = w;
                    }
                }
        }
    }
};

__device__ __forceinline__ void transpose_item(const float* W, int N, bf16* WT, int K, int k0, int n0, int drow0, const float* gk, LAS float* scr, int lane) {
    float wv[32];
#pragma unroll
    for (int i = 0; i < 32; ++i) wv[i] = W[(size_t)(k0 + 2 * i + (lane >> 5)) * N + n0 + (lane & 31)];
#pragma unroll
    for (int i = 0; i < 32; ++i) { const int kk = 2 * i + (lane >> 5); float v = wv[i]; if (gk) v *= gk[kk]; scr[kk * 33 + (lane & 31)] = v; }
    lds_wait();
    const int c = lane & 7;
#pragma unroll
    for (int j = 0; j < 4; ++j) { const int n = (lane >> 3) + 8 * j; const LAS float* s = scr + (8 * c) * 33 + n;
        u32x4 o; o.x = pk2(s[0 * 33], s[1 * 33]); o.y = pk2(s[2 * 33], s[3 * 33]); o.z = pk2(s[4 * 33], s[5 * 33]); o.w = pk2(s[6 * 33], s[7 * 33]);
        *(u32x4*)(WT + (size_t)(drow0 + n) * K + k0 + 8 * c) = o; }
    lds_wait();
}
constexpr int IT_BIG = 1408, IT_OUT = 512, IT_GLU = 32, IT_LW = 8;
constexpr int IT_LAYER = 7 * IT_BIG + IT_OUT + IT_GLU + 2 * IT_LW;
__device__ __forceinline__ void p0_weight_item(const Args& a, int l, int r, LAS float* scr, int lane) {
    unsigned char* wl = a.ws + WS_W + (size_t)l * WL_STRIDE;
#pragma unroll
    for (int f = 0; f < 2; ++f) {
        const float* nrm = a.in[f ? 28 : 1] + (size_t)l * DM;
        bf16* gu = (bf16*)(wl + (f ? WL_GU2 : WL_GU1)); bf16* dn = (bf16*)(wl + (f ? WL_D2 : WL_D1));
        if (r < 2 * IT_BIG) { const int up = r >= IT_BIG; const int it = r - up * IT_BIG; const int kb = it / 88, nb = it % 88, k0 = 64 * kb, n0 = 32 * nb;
            const float* W = a.in[(f ? 29 : 2) + up] + (size_t)l * DM * FF;
            transpose_item(W, FF, gu, DM, k0, n0, (n0 >> 7) * 256 + up * 128 + (n0 & 127), nrm + k0, scr, lane); return; }
        r -= 2 * IT_BIG;
        if (r < IT_BIG) { const int kb = r / 32, nb = r % 32; const float* W = a.in[f ? 31 : 4] + (size_t)l * FF * DM;
            transpose_item(W, DM, dn, FF, 64 * kb, 32 * nb, 32 * nb, nullptr, scr, lane); return; }
        r -= IT_BIG;
    }
    if (r < IT_BIG) {
        const int kb = r / 88, nb = r % 88, k0 = 64 * kb, n0 = 32 * nb; const int tile = n0 >> 8, c0 = n0 & 255;
        int drow = n0;
        if (tile >= 1 && tile <= 4) { const int hh = c0 >> 7, d0 = c0 & 127, bj = d0 >> 6, dd0 = d0 & 63; drow = tile * 256 + bj * 128 + hh * 64 + dd0; }
        transpose_item(a.in[6] + (size_t)l * DM * IW, IW, (bf16*)(wl + WL_WIN), DM, k0, n0, drow, a.in[5] + (size_t)l * DM + k0, scr, lane); return; }
    r -= IT_BIG;
    if (r < IT_OUT) {
        const int kb = r / 32, nb = r % 32, k0 = 64 * kb;
        const float* gk = (k0 < 256) ? a.in[17] + (size_t)l * 256 + k0 : (k0 < 768 ? a.in[18] + (size_t)l * 512 + (k0 - 256) : a.in[26] + (size_t)l * 256 + (k0 - 768));
        transpose_item(a.in[27] + (size_t)l * DM * DM, DM, (bf16*)(wl + WL_WOUT), DM, k0, 32 * nb, 32 * nb, gk, scr, lane); return; }
    r -= IT_OUT;
    if (r < IT_GLU) { const int kb = r / 8, nb = r % 8; transpose_item(a.in[15] + (size_t)l * 65536, 256, (bf16*)(wl + WL_GLU), 256, 64 * kb, 32 * nb, 32 * nb, nullptr, scr, lane); return; }
    r -= IT_GLU;
    if (r < IT_LW) { const int blk = r >> 1, nb = r & 1; transpose_item(a.in[21] + (size_t)l * 16384 + blk * 4096, 64, (bf16*)(wl + WL_WA) + blk * 4096, 64, 0, 32 * nb, 32 * nb, nullptr, scr, lane); return; }
    r -= IT_LW;
    { const int blk = r >> 1, nb = r & 1; transpose_item(a.in[23] + (size_t)l * 16384 + blk * 4096, 64, (bf16*)(wl + WL_WX) + blk * 4096, 64, 0, 32 * nb, 32 * nb, nullptr, scr, lane); }
}
__device__ __forceinline__ float wave_sum(float v) {
#pragma unroll
    for (int o = 1; o < 64; o <<= 1) v += __shfl_xor(v, o);
    return v;
}
__device__ __forceinline__ void p0_prologue(const Args& a, LAS unsigned char* lds, int tid, int lane, int wave, int G) {
    LAS float* scr = (LAS float*)(lds + wave * 8448);
    const int gw = blockIdx.x * NWAVE + wave, NGW = G * NWAVE;
    for (int it = gw; it < (G == 256 ? 1 : NL) * IT_LAYER; it += NGW) p0_weight_item(a, it / IT_LAYER, it % IT_LAYER, scr, lane);
    const float* x = a.in[0]; bf16* xb = (bf16*)(a.ws + WS_XB); float* ssq = (float*)(a.ws + WS_SSQ);
    for (int m = gw; m < NTOK; m += NGW) {
        const f32x4* xr = (const f32x4*)(x + (size_t)m * DM) + lane; u32x2* brow = (u32x2*)(xb + (size_t)m * DM) + lane;
        float s = 0.f;
#pragma unroll
        for (int j = 0; j < 4; ++j) { const f32x4 v = xr[64 * j]; u32x2 w; w.x = pk2(v.x, v.y); w.y = pk2(v.z, v.w); brow[64 * j] = w; s += (v.x * v.x + v.y * v.y) + (v.z * v.z + v.w * v.w); }
        s = wave_sum(s);
        if (lane < 16) ssq[(size_t)m * 16 + lane] = (lane == 0) ? s : 0.f;
    }
    const int gt = blockIdx.x * NTHR + tid, NGT = G * NTHR;
    float* rcos = (float*)(a.ws + WS_ROPE); float* rsin = rcos + SEQ * 64;
    for (int i = gt; i < SEQ * 64; i += NGT) { const int pos = i >> 6, k = i & 63; const float inv = powf(10000.0f, -(float)(2 * k) / 128.0f); const float ang = (float)pos * inv; rcos[i] = cosf(ang); rsin[i] = sinf(ang); }
    for (int i = gt; i < NL * 16 * 64; i += NGT) {
        const int p = i & 63, lg = i >> 6, l = lg >> 4, g = lg & 15;
        const float lre = a.in[7][i], lim = a.in[8][i], step = expf(a.in[9][lg]);
        const float ar = lre * step, ai = lim * step, mag = expf(ar), lbr = mag * cosf(ai), lbi = mag * sinf(ai);
        const float nr = lbr - 1.0f, den = lre * lre + lim * lim, fr = (nr * lre + lbi * lim) / den, fi = (lbi * lre - nr * lim) / den;
        float* tab = (float*)(a.ws + WS_W + (size_t)l * WL_STRIDE + WL_S5T) + (size_t)g * 36 * 64 + p;
        float cr = lbr, ci = lbi;
#pragma unroll
        for (int q = 0; q < 6; ++q) { const float t = cr * cr - ci * ci; ci = 2.0f * cr * ci; cr = t; }
        tab[0] = lbr; tab[64] = lbi; tab[128] = cr; tab[192] = ci;
        for (int h = 0; h < 16; ++h) { const float br = a.in[10][(size_t)i * 16 + h], bi = a.in[11][(size_t)i * 16 + h]; const float bbr = fr * br - fi * bi, bbi = fr * bi + fi * br; tab[(4 + h) * 64] = bbr; tab[(20 + h) * 64] = bbi;
            bf16* BB = (bf16*)(a.ws + WS_W + (size_t)l * WL_STRIDE + WL_BB); const unsigned pr = pk2(bbr, bbi);
            BB[(size_t)(g * 128 + p) * 16 + h] = (bf16)(pr & 0xffffu); BB[(size_t)(g * 128 + 64 + p) * 16 + h] = (bf16)(pr >> 16); }
    }
    for (int i = gt; i < NL * 16 * 16 * 128; i += NGT) {
        const int k = i & 127, lgh = i >> 7, l = lgh >> 8;
        const float v = (k < 64) ? a.in[12][(size_t)lgh * 64 + k] : -a.in[13][(size_t)lgh * 64 + (k - 64)];
        ((bf16*)(a.ws + WS_W + (size_t)l * WL_STRIDE + WL_CM))[i & 32767] = (bf16)(pk2(v, 0.f) & 0xffffu);
    }
    for (int i = gt; i < NL * 256; i += NGT) { const float lam = a.in[25][i]; const float sp = (lam > 15.f) ? expf(-lam) : log1pf(expf(-lam)); ((float*)(a.ws + WS_TAB))[i] = -8.0f * sp; }
}

__device__ __forceinline__ void tail_convert(const Args& a, int l, int slot, LAS unsigned char* lds) {
    if (l >= NL) return;
    int tid = threadIdx.x; asm volatile("" : "+v"(tid)); const int lane = tid & 63, wave = __builtin_amdgcn_readfirstlane(tid >> 6);
    LAS float* scr = (LAS float*)(lds + wave * 8448);
    for (int it = slot * NWAVE + wave; it < IT_LAYER; it += 320 * NWAVE) p0_weight_item(a, l, it, scr, lane);
    __syncthreads();
}
constexpr int OFF_BUS = 0, BUS_WAVE = 8448, OFF_SST = 67584, SST_WAVE = 4352, OFF_YS = 102400, OFF_RED2 = 136192;
template <bool FULL> __device__ __forceinline__ void s5_group(const Args& a, int l, int tile, int g, LAS unsigned char* lds, int lane, int wave) {
    const bf16* Z = (const bf16*)(a.ws + WS_HZ);
    const int t0 = tile * 64, fr = lane & 15, fq = lane >> 4;
    unsigned char* wl = a.ws + WS_W + (size_t)l * WL_STRIDE;
    const float* tab = (const float*)(wl + WL_S5T) + (size_t)g * 36 * 64; const bf16* BB = (const bf16*)(wl + WL_BB); const bf16* CM = (const bf16*)(wl + WL_CM);
    float* E = (float*)(a.ws + WS_S5E);
    LAS unsigned char* bus = lds + OFF_BUS + wave * BUS_WAVE; LAS unsigned char* sst = lds + OFF_SST + wave * SST_WAVE;
    const float lbr = tab[lane], lbi = tab[64 + lane];
    const bf16x8 zero8 = {0, 0, 0, 0, 0, 0, 0, 0};
    bf16x8 bbf[8];
#pragma unroll
    for (int kt = 0; kt < 8; ++kt) { bbf[kt] = zero8; if (fq < 2) bbf[kt] = *(const bf16x8*)(BB + (size_t)(g * 128 + kt * 16 + fr) * 16 + 8 * fq); }
    float sre = 0.f, sim = 0.f;
    bf16x8 cm[4]; f32x4 dsk;
    if (FULL) {
        sre = E[((size_t)(tile * 16 + g) * 2 + 0) * 64 + lane]; sim = E[((size_t)(tile * 16 + g) * 2 + 1) * 64 + lane];
#pragma unroll
        for (int ks = 0; ks < 4; ++ks) cm[ks] = *(const bf16x8*)(CM + (size_t)(g * 16 + fr) * 128 + 32 * ks + 8 * fq);
        dsk = *(const f32x4*)(a.in[14] + (size_t)l * 256 + g * 16 + 4 * fq);
    }
    bf16x8 ufa[4]; u32x2 urawa[4];
#pragma unroll
    for (int tb = 0; tb < 4; ++tb) { const bf16* zr = Z + (size_t)(t0 + tb * 16 + fr) * IW + g * 16;
        ufa[tb] = zero8; if (fq < 2) ufa[tb] = *(const bf16x8*)(zr + 8 * fq);
        if (FULL) urawa[tb] = *(const u32x2*)(zr + 4 * fq); }
#pragma unroll
    for (int tb = 0; tb < 4; ++tb) {
        const bf16x8 uf = ufa[tb]; u32x2 uraw; if (FULL) uraw = urawa[tb];
#pragma unroll
        for (int kt = 0; kt < 8; ++kt) { f32x4 d = {0.f, 0.f, 0.f, 0.f}; MFMA16(bbf[kt], uf, d); *(LAS f32x4*)(bus + (fr * 132 + kt * 16 + 4 * fq) * 4) = d; }
        lds_wait();
        float bra[16], bia[16];
#pragma unroll
        for (int tt = 0; tt < 16; ++tt) { bra[tt] = *(const LAS float*)(bus + (tt * 132 + lane) * 4); bia[tt] = *(const LAS float*)(bus + (tt * 132 + 64 + lane) * 4); }
#pragma unroll
        for (int tt = 0; tt < 16; ++tt) {
            const float br = bra[tt], bi = bia[tt];
            const float nre = lbr * sre - lbi * sim + br, nim = lbr * sim + lbi * sre + bi; sre = nre; sim = nim;
            if (FULL) { const unsigned pr = pk2(sre, sim);
                *(LAS bf16*)(sst + (tt * 136 + lane) * 2) = (bf16)(pr & 0xffffu); *(LAS bf16*)(sst + (tt * 136 + 64 + lane) * 2) = (bf16)(pr >> 16); }
        }
        if (FULL) {
            lds_wait();
            f32x4 acc = {0.f, 0.f, 0.f, 0.f};
#pragma unroll
            for (int ks = 0; ks < 4; ++ks) { const bf16x8 yv = *(const LAS bf16x8*)(sst + (fr * 136 + 32 * ks + 8 * fq) * 2); MFMA16(cm[ks], yv, acc); }
            const int t = tb * 16 + fr;
            f32x4 u4; u4.x = __uint_as_float(uraw.x << 16); u4.y = __uint_as_float(uraw.x & 0xffff0000u); u4.z = __uint_as_float(uraw.y << 16); u4.w = __uint_as_float(uraw.y & 0xffff0000u);
            const f32x4 v = acc + dsk * u4;
            u32x2 w; w.x = pk2(geluf_(v.x), geluf_(v.y)); w.y = pk2(geluf_(v.z), geluf_(v.w));
            *(LAS u32x2*)(lds + OFF_YS + (t * 264 + g * 16 + 4 * fq) * 2) = w;
        }
        lds_wait();
    }
    if (!FULL) { E[((size_t)(tile * 16 + g) * 2 + 0) * 64 + lane] = sre; E[((size_t)(tile * 16 + g) * 2 + 1) * 64 + lane] = sim; }
}
__device__ __forceinline__ void s5_m1(const Args& a, int l, int tile, LAS unsigned char* lds, int tid, int lane, int wave) {
    for (int gi = 0; gi < 2; ++gi) s5_group<false>(a, l, tile, wave * 2 + gi, lds, lane, wave);
    __syncthreads();
}
__device__ __forceinline__ void s5_m3(const Args& a, int l, int tile, LAS unsigned char* lds, int tid, int lane, int wave) {
    bf16* Y = (bf16*)(a.ws + WS_Y);
    const int t0 = tile * 64, fr = lane & 15, fq = lane >> 4;
    unsigned char* wl = a.ws + WS_W + (size_t)l * WL_STRIDE;
    for (int gi = 0; gi < 2; ++gi) s5_group<true>(a, l, tile, wave * 2 + gi, lds, lane, wave);
    __syncthreads();
    {
        const int cb = wave & 3, jh = wave >> 2; const bf16* WG = (const bf16*)(wl + WL_GLU);
        f32x4 acc[8];
#pragma unroll
        for (int jt = 0; jt < 8; ++jt) acc[jt] = (f32x4){0.f, 0.f, 0.f, 0.f};
#pragma unroll
        for (int ks = 0; ks < 8; ++ks) {
            const bf16x8 yv = *(const LAS bf16x8*)(lds + OFF_YS + ((cb * 16 + fr) * 264 + 32 * ks + 8 * fq) * 2);
#pragma unroll
            for (int jt = 0; jt < 8; ++jt) { const bf16x8 wv = *(const bf16x8*)(WG + (size_t)(jh * 128 + jt * 16 + fr) * 256 + 32 * ks + 8 * fq); MFMA16(wv, yv, acc[jt]); }
        }
        const int t = cb * 16 + fr; float ss = 0.f;
#pragma unroll
        for (int jt = 0; jt < 8; ++jt) {
            const int j0 = jh * 128 + jt * 16 + 4 * fq;
            const f32x4 bg = *(const f32x4*)(a.in[16] + (size_t)l * 256 + j0);
            const u32x2 yr = *(const LAS u32x2*)(lds + OFF_YS + (t * 264 + j0) * 2);
            f32x4 o;
            o.x = __uint_as_float(yr.x << 16) * sigmoidf_(acc[jt].x + bg.x); o.y = __uint_as_float(yr.x & 0xffff0000u) * sigmoidf_(acc[jt].y + bg.y);
            o.z = __uint_as_float(yr.y << 16) * sigmoidf_(acc[jt].z + bg.z); o.w = __uint_as_float(yr.y & 0xffff0000u) * sigmoidf_(acc[jt].w + bg.w);
            acc[jt] = o; ss += (o.x * o.x + o.y * o.y) + (o.z * o.z + o.w * o.w);
        }
        ss += __shfl_xor(ss, 16); ss += __shfl_xor(ss, 32);
        LAS float* red = (LAS float*)(lds + OFF_RED2);
        if (fq == 0) red[t * 2 + jh] = ss;
        __syncthreads();
        const float rstd = rsqrtf((red[t * 2] + red[t * 2 + 1]) * (1.0f / 256.0f) + EPS);
#pragma unroll
        for (int jt = 0; jt < 8; ++jt) { const int j0 = jh * 128 + jt * 16 + 4 * fq; u32x2 w; w.x = pk2(acc[jt].x * rstd, acc[jt].y * rstd); w.y = pk2(acc[jt].z * rstd, acc[jt].w * rstd);
            *(u32x2*)(Y + (size_t)(t0 + t) * DM + j0) = w; }
    }
    __syncthreads();
}

constexpr int OFF_LA = 0, OFF_LB = 65536, OFF_XC = 65536;
template <bool FULL> __device__ __forceinline__ void lru_tile(const Args& a, int l, int tile, LAS unsigned char* lds, int tid, int lane, int wave) {
    const bf16* Z = (const bf16*)(a.ws + WS_HZ); bf16* Y = (bf16*)(a.ws + WS_Y);
    const int t0 = tile * 64, fr = lane & 15, fq = lane >> 4; const int tloc0 = (tile & 127) * 64;
    unsigned char* wl = a.ws + WS_W + (size_t)l * WL_STRIDE;
#pragma unroll
    for (int it = 0; it < 4; ++it) {
        const int ch = it * NTHR + tid, t = ch >> 5, c8 = ch & 31;
        float xc[8];
        { const f32x4 b0 = *(const f32x4*)(a.in[20] + (size_t)l * 256 + c8 * 8), b1 = *(const f32x4*)(a.in[20] + (size_t)l * 256 + c8 * 8 + 4);
          xc[0] = b0.x; xc[1] = b0.y; xc[2] = b0.z; xc[3] = b0.w; xc[4] = b1.x; xc[5] = b1.y; xc[6] = b1.z; xc[7] = b1.w; }
#pragma unroll
        for (int j = 0; j < 4; ++j) {
            if (tloc0 + t + j - 3 >= 0) {
                const u32x4 v = *(const u32x4*)(Z + (size_t)(t0 + t + j - 3) * IW + 2304 + c8 * 8); float f[8]; unpack8(v, f);
                const f32x4 w0 = *(const f32x4*)(a.in[19] + ((size_t)l * 4 + j) * 256 + c8 * 8), w1 = *(const f32x4*)(a.in[19] + ((size_t)l * 4 + j) * 256 + c8 * 8 + 4);
                xc[0] = fmaf(w0.x, f[0], xc[0]); xc[1] = fmaf(w0.y, f[1], xc[1]); xc[2] = fmaf(w0.z, f[2], xc[2]); xc[3] = fmaf(w0.w, f[3], xc[3]);
                xc[4] = fmaf(w1.x, f[4], xc[4]); xc[5] = fmaf(w1.y, f[5], xc[5]); xc[6] = fmaf(w1.z, f[6], xc[6]); xc[7] = fmaf(w1.w, f[7], xc[7]);
            }
        }
        u32x4 w; w.x = pk2(xc[0], xc[1]); w.y = pk2(xc[2], xc[3]); w.z = pk2(xc[4], xc[5]); w.w = pk2(xc[6], xc[7]);
        *(LAS u32x4*)(lds + OFF_XC + (t * 264 + c8 * 8) * 2) = w;
    }
    __syncthreads();
    {
        const int cb = wave & 3, chh = wave >> 2; const bf16* WA = (const bf16*)(wl + WL_WA); const bf16* WX = (const bf16*)(wl + WL_WX);
        const float* c8t = (const float*)(a.ws + WS_TAB) + (size_t)l * 256;
        f32x4 av[8], bv[8];
#pragma unroll
        for (int et = 0; et < 8; ++et) {
            const int e0 = chh * 128 + et * 16, nb = e0 >> 6, el = e0 & 63;
            f32x4 ra = {0.f, 0.f, 0.f, 0.f}, ia = {0.f, 0.f, 0.f, 0.f};
#pragma unroll
            for (int ks = 0; ks < 2; ++ks) {
                const bf16x8 xv = *(const LAS bf16x8*)(lds + OFF_XC + ((cb * 16 + fr) * 264 + nb * 64 + 32 * ks + 8 * fq) * 2);
                const bf16x8 wa = *(const bf16x8*)(WA + (size_t)nb * 4096 + (el + fr) * 64 + 32 * ks + 8 * fq);
                const bf16x8 wx = *(const bf16x8*)(WX + (size_t)nb * 4096 + (el + fr) * 64 + 32 * ks + 8 * fq);
                MFMA16(wa, xv, ra); MFMA16(wx, xv, ia);
            }
            const int c0 = e0 + 4 * fq;
            const f32x4 ba = *(const f32x4*)(a.in[22] + (size_t)l * 256 + c0), bx = *(const f32x4*)(a.in[24] + (size_t)l * 256 + c0), c8v = *(const f32x4*)(c8t + c0);
            const u32x2 xr = *(const LAS u32x2*)(lds + OFF_XC + ((cb * 16 + fr) * 264 + c0) * 2);
            const float xcv[4] = {__uint_as_float(xr.x << 16), __uint_as_float(xr.x & 0xffff0000u), __uint_as_float(xr.y << 16), __uint_as_float(xr.y & 0xffff0000u)};
#pragma unroll
            for (int r = 0; r < 4; ++r) {
                const float rg = sigmoidf_(ra[r] + ba[r]), ig = sigmoidf_(ia[r] + bx[r]);
                const float la = c8v[r] * rg; const float av_ = __expf(la); const float m2 = -expm1f(2.0f * la);
                av[et][r] = av_; bv[et][r] = sqrtf(fmaxf(m2, 0.f)) * ig * xcv[r];
            }
        }
        __syncthreads();
#pragma unroll
        for (int et = 0; et < 8; ++et) { const int c0 = chh * 128 + et * 16 + 4 * fq, t = cb * 16 + fr;
            *(LAS f32x4*)(lds + OFF_LA + (t * 256 + c0) * 4) = av[et]; *(LAS f32x4*)(lds + OFF_LB + (t * 256 + c0) * 4) = bv[et]; }
    }
    __syncthreads();
    float* AE = (float*)(a.ws + WS_LRUC); float* HE = AE + 2 * 128 * 256;
    if (tid < 256) {
        LAS float* A = (LAS float*)(lds + OFF_LA) + tid; LAS float* B = (LAS float*)(lds + OFF_LB) + tid;
        float h = FULL ? HE[(size_t)tile * 256 + tid] : 0.f, P = 1.f;
        for (int tb = 0; tb < 64; tb += 16) {
            float av_[16], bv_[16];
#pragma unroll
            for (int j = 0; j < 16; ++j) { av_[j] = A[(tb + j) * 256]; bv_[j] = B[(tb + j) * 256]; }
#pragma unroll
            for (int j = 0; j < 16; ++j) { h = fmaf(av_[j], h, bv_[j]); if (FULL) bv_[j] = h; else P *= av_[j]; }
            if (FULL) {
#pragma unroll
                for (int j = 0; j < 16; ++j) B[(tb + j) * 256] = bv_[j];
            }
        }
        if (!FULL) { AE[(size_t)tile * 256 + tid] = P; HE[(size_t)tile * 256 + tid] = h; }
    }
    __syncthreads();
    if (FULL) {
#pragma unroll
        for (int it = 0; it < 4; ++it) {
            const int ch = it * NTHR + tid, t = ch >> 5, c8 = ch & 31;
            const LAS f32x4* hp = (const LAS f32x4*)(lds + OFF_LB + (t * 256 + c8 * 8) * 4); const f32x4 h0 = hp[0], h1 = hp[1];
            const u32x4 gv = *(const u32x4*)(Z + (size_t)(t0 + t) * IW + 2560 + c8 * 8); float g[8]; unpack8(gv, g);
            float o[8] = {h0.x * g[0], h0.y * g[1], h0.z * g[2], h0.w * g[3], h1.x * g[4], h1.y * g[5], h1.z * g[6], h1.w * g[7]};
            float ss = 0.f;
#pragma unroll
            for (int i = 0; i < 8; ++i) ss += o[i] * o[i];
#pragma unroll
            for (int s = 1; s < 32; s <<= 1) ss += __shfl_xor(ss, s);
            const float rstd = rsqrtf(ss * (1.0f / 256.0f) + EPS);
            u32x4 w; w.x = pk2(o[0] * rstd, o[1] * rstd); w.y = pk2(o[2] * rstd, o[3] * rstd); w.z = pk2(o[4] * rstd, o[5] * rstd); w.w = pk2(o[6] * rstd, o[7] * rstd);
            *(u32x4*)(Y + (size_t)(t0 + t) * DM + 768 + c8 * 8) = w;
        }
        __syncthreads();
    }
}

constexpr int OFF_QS = 0, OFF_KS = 17408, OFF_VT = 52224, OFF_PT = 87040, OFF_SS = 121856, OFF_RED = 139264;
__device__ __forceinline__ float ret_lg2(int h) { return log2f(1.0f - exp2f(-5.0f - (float)h)); }
typedef short s16x4 __attribute__((ext_vector_type(4)));
__device__ __forceinline__ bf16x8 tr_frag(LAS unsigned char* base, int stride, int k0, int c0, int lane) {
    const int fq = lane >> 4, q = (lane & 15) >> 2, p = lane & 3;
    LAS unsigned char* a0 = base + (k0 + 8 * fq + q) * stride + (c0 + 4 * p) * 2;
    const s16x4 lo = __builtin_amdgcn_ds_read_tr16_b64_v4i16((LAS s16x4*)a0);
    const s16x4 hi = __builtin_amdgcn_ds_read_tr16_b64_v4i16((LAS s16x4*)(a0 + 4 * stride));
    return (bf16x8){lo[0], lo[1], lo[2], lo[3], hi[0], hi[1], hi[2], hi[3]};
}
template <int NR, bool ZETA> __device__ __forceinline__ void ret_load_R(const bf16* Z, int r0, int c0, LAS unsigned char* dst, int tid, float lg2) {
#pragma unroll
    for (int it = 0; it < NR / 32; ++it) { const int ch = it * NTHR + tid, r = ch >> 4, c = ch & 15;
        u32x4 v = *(const u32x4*)(Z + (size_t)(r0 + r) * IW + c0 + c * 8);
        if (ZETA) { const float zs = exp2f((float)(127 - r) * lg2); float f[8]; unpack8(v, f);
            v.x = pk2(f[0] * zs, f[1] * zs); v.y = pk2(f[2] * zs, f[3] * zs); v.z = pk2(f[4] * zs, f[5] * zs); v.w = pk2(f[6] * zs, f[7] * zs); }
        *(LAS u32x4*)(dst + (r * 136 + c * 8) * 2) = v; }
}
template <bool ZETA> __device__ __forceinline__ void ret_load_T(const bf16* Z, int r0, int c0, LAS unsigned char* dst, int tid, float lg2) {
    const int m = tid & 127; const float zs = ZETA ? exp2f((float)(127 - m) * lg2) : 1.0f;
#pragma unroll
    for (int it = 0; it < 4; ++it) { const int dc = (tid >> 7) + 4 * it;
        const u32x4 v = *(const u32x4*)(Z + (size_t)(r0 + m) * IW + c0 + dc * 8); float f[8]; unpack8(v, f);
#pragma unroll
        for (int i = 0; i < 8; i += 2) { const unsigned pr = pk2(f[i] * zs, f[i + 1] * zs);
            *(LAS bf16*)(dst + ((dc * 8 + i) * 136 + m) * 2) = (bf16)(pr & 0xffffu); *(LAS bf16*)(dst + ((dc * 8 + i + 1) * 136 + m) * 2) = (bf16)(pr >> 16); }
    }
}
__device__ __forceinline__ void ret_kv(const Args& a, int unit, LAS unsigned char* lds, int tid, int lane, int wave) {
    const bf16* Z = (const bf16*)(a.ws + WS_HZ);
    const int n = unit & 63, bh = unit >> 6, h = bh & 3, b = bh >> 2, r0 = b * SEQ + n * 128, fr = lane & 15, fq = lane >> 4;
    const float lg2 = ret_lg2(h);
    ret_load_R<128, true>(Z, r0, 768 + h * 128, lds + OFF_KS, tid, lg2);
    ret_load_R<128, false>(Z, r0, 1280 + h * 128, lds + OFF_VT, tid, lg2);
    __syncthreads();
    const int eb = (wave & 3) * 32, dh = (wave >> 2) * 64;
    f32x4 acc[2][4];
#pragma unroll
    for (int i = 0; i < 2; ++i)
#pragma unroll
        for (int j = 0; j < 4; ++j) acc[i][j] = (f32x4){0.f, 0.f, 0.f, 0.f};
#pragma unroll
    for (int ks = 0; ks < 4; ++ks) {
        bf16x8 vf[2], kf[4];
#pragma unroll
        for (int i = 0; i < 2; ++i) vf[i] = tr_frag(lds + OFF_VT, 272, 32 * ks, eb + i * 16, lane);
#pragma unroll
        for (int j = 0; j < 4; ++j) kf[j] = tr_frag(lds + OFF_KS, 272, 32 * ks, dh + j * 16, lane);
#pragma unroll
        for (int i = 0; i < 2; ++i)
#pragma unroll
            for (int j = 0; j < 4; ++j) MFMA16(kf[j], vf[i], acc[i][j]);
        asm volatile("" ::: "memory");
    }
    float* KV = (float*)(a.ws + WS_KV) + (size_t)unit * 16384;
#pragma unroll
    for (int i = 0; i < 2; ++i)
#pragma unroll
        for (int j = 0; j < 4; ++j) *(f32x4*)(KV + (size_t)(eb + i * 16 + fr) * 128 + dh + j * 16 + 4 * fq) = acc[i][j];
    __syncthreads();
}
__device__ __forceinline__ void ret_out(const Args& a, int tile, LAS unsigned char* lds, int tid, int lane, int wave) {
    const bf16* Z = (const bf16*)(a.ws + WS_HZ); bf16* Y = (bf16*)(a.ws + WS_Y); const bf16* PB = (const bf16*)(a.ws + WS_PB);
    const int b = tile >> 7, n = (tile & 127) >> 1, half = tile & 1, t0 = tile * 64, k0 = b * SEQ + n * 128, fr = lane & 15, fq = lane >> 4;
    const int cb = wave & 3, hv = wave >> 2;
    const int cg = half * 64 + cb * 16 + fr;
    const int nit = half ? 4 : 2;
    LAS float* red = (LAS float*)(lds + OFF_RED);
    const int lr = tid >> 4, lc = tid & 15;
    u32x4 rq[2], rk[4], rv[4], rp[4];
#define RET_ISSUE(h_) do { \
        _Pragma("unroll") for (int it = 0; it < 2; ++it) rq[it] = *(const u32x4*)(Z + (size_t)(t0 + it * 32 + lr) * IW + 256 + (h_) * 128 + lc * 8); \
        _Pragma("unroll") for (int it = 0; it < 4; ++it) if (it < nit) { rk[it] = *(const u32x4*)(Z + (size_t)(k0 + it * 32 + lr) * IW + 768 + (h_) * 128 + lc * 8); \
                                                                          rv[it] = *(const u32x4*)(Z + (size_t)(k0 + it * 32 + lr) * IW + 1280 + (h_) * 128 + lc * 8); } \
        { const bf16* P_ = PB + (size_t)(((b * 4 + (h_)) * 64) + n) * 16384; \
          _Pragma("unroll") for (int it = 0; it < 4; ++it) rp[it] = *(const u32x4*)(P_ + (size_t)(it * 32 + lr) * 128 + lc * 8); } } while (0)
    RET_ISSUE(0);
    float ss512 = 0.f;
#pragma unroll 1
    for (int h = 0; h < 4; ++h) {
        const float lg2 = ret_lg2(h);
#pragma unroll
        for (int it = 0; it < 2; ++it) *(LAS u32x4*)(lds + OFF_QS + ((it * 32 + lr) * 136 + lc * 8) * 2) = rq[it];
#pragma unroll
        for (int it = 0; it < 4; ++it) if (it < nit) { *(LAS u32x4*)(lds + OFF_KS + ((it * 32 + lr) * 136 + lc * 8) * 2) = rk[it]; *(LAS u32x4*)(lds + OFF_VT + ((it * 32 + lr) * 136 + lc * 8) * 2) = rv[it]; }
#pragma unroll
        for (int it = 0; it < 4; ++it) *(LAS u32x4*)(lds + OFF_PT + ((it * 32 + lr) * 136 + lc * 8) * 2) = rp[it];
        __syncthreads();
        if (h < 3) RET_ISSUE(h + 1);
        u32x2 gr[4];
#pragma unroll
        for (int et = 0; et < 4; ++et) gr[et] = *(const u32x2*)(Z + (size_t)(t0 + cb * 16 + fr) * IW + 1792 + h * 128 + hv * 64 + et * 16 + 4 * fq);
        if (hv == 0 || half) {
            f32x4 sc[4];
#pragma unroll
            for (int mt = 0; mt < 4; ++mt) sc[mt] = (f32x4){0.f, 0.f, 0.f, 0.f};
#pragma unroll
            for (int ks = 0; ks < 4; ++ks) {
                const bf16x8 qf = *(const LAS bf16x8*)(lds + OFF_QS + ((cb * 16 + fr) * 136 + 32 * ks + 8 * fq) * 2);
#pragma unroll
                for (int mt = 0; mt < 4; ++mt) { const bf16x8 kf = *(const LAS bf16x8*)(lds + OFF_KS + ((hv * 64 + mt * 16 + fr) * 136 + 32 * ks + 8 * fq) * 2); MFMA16(kf, qf, sc[mt]); }
            }
#pragma unroll
            for (int mt = 0; mt < 4; ++mt) { const int m0 = hv * 64 + mt * 16 + 4 * fq; float v[4];
#pragma unroll
                for (int r = 0; r < 4; ++r) { const int dm = cg - (m0 + r); v[r] = (dm >= 0) ? sc[mt][r] * exp2f((float)dm * lg2) : 0.f; }
                u32x2 w; w.x = pk2(v[0], v[1]); w.y = pk2(v[2], v[3]);
                *(LAS u32x2*)(lds + OFF_SS + ((cb * 16 + fr) * 136 + m0) * 2) = w; }
        }
        __syncthreads();
        f32x4 oi[4], oc[4];
#pragma unroll
        for (int et = 0; et < 4; ++et) { oi[et] = (f32x4){0.f, 0.f, 0.f, 0.f}; oc[et] = (f32x4){0.f, 0.f, 0.f, 0.f}; }
#pragma unroll
        for (int ks = 0; ks < 4; ++ks) {
            const bf16x8 qf = *(const LAS bf16x8*)(lds + OFF_QS + ((cb * 16 + fr) * 136 + 32 * ks + 8 * fq) * 2);
#pragma unroll
            for (int et = 0; et < 4; ++et) { const bf16x8 pf = *(const LAS bf16x8*)(lds + OFF_PT + ((hv * 64 + et * 16 + fr) * 136 + 32 * ks + 8 * fq) * 2); MFMA16(pf, qf, oc[et]); }
            if (ks < nit) {
                const bf16x8 sf = *(const LAS bf16x8*)(lds + OFF_SS + ((cb * 16 + fr) * 136 + 32 * ks + 8 * fq) * 2);
#pragma unroll
                for (int et = 0; et < 4; ++et) { const bf16x8 vf = tr_frag(lds + OFF_VT, 272, 32 * ks, hv * 64 + et * 16, lane); MFMA16(vf, sf, oi[et]); }
            }
        }
        const float xi = exp2f((float)(cg + 1) * lg2);
        float ss = 0.f;
#pragma unroll
        for (int et = 0; et < 4; ++et) { oi[et] = oi[et] + oc[et] * xi; ss += (oi[et].x * oi[et].x + oi[et].y * oi[et].y) + (oi[et].z * oi[et].z + oi[et].w * oi[et].w); }
        ss += __shfl_xor(ss, 16); ss += __shfl_xor(ss, 32);
        if (fq == 0) red[(h * 64 + cb * 16 + fr) * 2 + hv] = ss;
        __syncthreads();
        const float rstd = rsqrtf((red[(h * 64 + cb * 16 + fr) * 2] + red[(h * 64 + cb * 16 + fr) * 2 + 1]) * (1.0f / 128.0f) + EPS);
#pragma unroll
        for (int et = 0; et < 4; ++et) {
            f32x4 o;
            o.x = oi[et].x * rstd * __uint_as_float(gr[et].x << 16); o.y = oi[et].y * rstd * __uint_as_float(gr[et].x & 0xffff0000u);
            o.z = oi[et].z * rstd * __uint_as_float(gr[et].y << 16); o.w = oi[et].w * rstd * __uint_as_float(gr[et].y & 0xffff0000u);
            ss512 += (o.x * o.x + o.y * o.y) + (o.z * o.z + o.w * o.w);
            u32x2 w; w.x = pk2(o.x, o.y); w.y = pk2(o.z, o.w);
            *(u32x2*)(Y + (size_t)(t0 + cb * 16 + fr) * DM + 256 + h * 128 + hv * 64 + et * 16 + 4 * fq) = w;
        }
    }
#undef RET_ISSUE
    ss512 += __shfl_xor(ss512, 16); ss512 += __shfl_xor(ss512, 32);
    LAS float* red5 = red + 512;
    if (fq == 0) red5[(cb * 16 + fr) * 2 + hv] = ss512;
    __syncthreads();
    const float rstd = rsqrtf((red5[(cb * 16 + fr) * 2] + red5[(cb * 16 + fr) * 2 + 1]) * (1.0f / 512.0f) + EPS);
#pragma unroll 1
    for (int h = 0; h < 4; ++h)
#pragma unroll
        for (int et = 0; et < 4; ++et) { u32x2* yp = (u32x2*)(Y + (size_t)(t0 + cb * 16 + fr) * DM + 256 + h * 128 + hv * 64 + et * 16 + 4 * fq); const u32x2 r = *yp;
            u32x2 w; w.x = pk2(__uint_as_float(r.x << 16) * rstd, __uint_as_float(r.x & 0xffff0000u) * rstd); w.y = pk2(__uint_as_float(r.y << 16) * rstd, __uint_as_float(r.y & 0xffff0000u) * rstd);
            *yp = w; }
    __syncthreads();
}

__device__ __forceinline__ void m2_scans(const Args& a, int l, int tid, int G) {
    const int gt = blockIdx.x * NTHR + tid, NGT = G * NTHR;
    for (int i = gt; i < 8 * 16384; i += NGT) {
        const int bh = i >> 14, ed = i & 16383, h = bh & 3;
        const float gC = exp2f(128.0f * ret_lg2(h));
        const float* p = (const float*)(a.ws + WS_KV) + (size_t)bh * 64 * 16384 + ed; bf16* pb = (bf16*)(a.ws + WS_PB) + (size_t)bh * 64 * 16384 + ed;
        float S = 0.f;
        {
            float v[64];
#pragma unroll
            for (int j = 0; j < 64; ++j) v[j] = p[(size_t)j * 16384];
#pragma unroll
            for (int j = 0; j < 64; ++j) { pb[(size_t)j * 16384] = (bf16)(pk2(S, 0.f) & 0xffffu); S = fmaf(gC, S, v[j]); }
        }
    }
    const int rt = NGT - 1 - gt;
    if (rt < 2048) {
        const int p = rt & 63, g = (rt >> 6) & 15, b = rt >> 10;
        const float* tab = (const float*)(a.ws + WS_W + (size_t)l * WL_STRIDE + WL_S5T) + (size_t)g * 36 * 64;
        const float cr = tab[128 + p], ci = tab[192 + p];
        float* E = (float*)(a.ws + WS_S5E);
        float sre = 0.f, sim = 0.f;
        for (int nb = 0; nb < 128; nb += 32) {
            float er[32], ei[32];
#pragma unroll
            for (int j = 0; j < 32; ++j) { const size_t o = ((size_t)((b * 128 + nb + j) * 16 + g) * 2) * 64 + p; er[j] = E[o]; ei[j] = E[o + 64]; }
#pragma unroll
            for (int j = 0; j < 32; ++j) { const size_t o = ((size_t)((b * 128 + nb + j) * 16 + g) * 2) * 64 + p; E[o] = sre; E[o + 64] = sim;
                const float nre = cr * sre - ci * sim + er[j], nim = cr * sim + ci * sre + ei[j]; sre = nre; sim = nim; }
        }
    } else if (rt < 2048 + 512) {
        const int q = rt - 2048, ch = q & 255, b = q >> 8;
        float* AE = (float*)(a.ws + WS_LRUC); float* HE = AE + 2 * 128 * 256;
        float hcar = 0.f;
        for (int nb = 0; nb < 128; nb += 32) {
            float av[32], hv[32];
#pragma unroll
            for (int j = 0; j < 32; ++j) { const size_t o = (size_t)(b * 128 + nb + j) * 256 + ch; av[j] = AE[o]; hv[j] = HE[o]; }
#pragma unroll
            for (int j = 0; j < 32; ++j) { const size_t o = (size_t)(b * 128 + nb + j) * 256 + ch; HE[o] = hcar; hcar = fmaf(av[j], hcar, hv[j]); }
        }
    }
}

__global__ void __launch_bounds__(NTHR, 2) fwd_kernel(Args a) {
    extern __shared__ __attribute__((aligned(16))) unsigned char lds_raw[];
    LAS unsigned char* lds = (LAS unsigned char*)lds_raw;
    cg::grid_group grid = cg::this_grid();
    const int G = gridDim.x;
#define PH_IDS int tid = threadIdx.x; asm volatile("" : "+v"(tid)); const int lane = tid & 63, wave = __builtin_amdgcn_readfirstlane(tid >> 6); (void)lane; (void)wave;
    bf16* XB = (bf16*)(a.ws + WS_XB); bf16* HZ = (bf16*)(a.ws + WS_HZ); bf16* Y = (bf16*)(a.ws + WS_Y); float* SSQ = (float*)(a.ws + WS_SSQ);
    const float* RC = (const float*)(a.ws + WS_ROPE); const float* RS = RC + SEQ * 64;

    volatile LAS unsigned* MISC = (volatile LAS unsigned*)(lds + MISC_OFF);
    if (threadIdx.x < 16) MISC[threadIdx.x] = 0u;
    __syncthreads();
    const XcdBarrier bar = xcd_barrier_post((unsigned*)(a.ws + WS_CTL) + CW_BAR, MISC + 8);
    { PH_IDS p0_prologue(a, lds, tid, lane, wave, G); }
    grid.sync();
#define GRID_BAR() xcd_barrier(bar)

    for (int l = 0; l < NL; ++l) {
        unsigned char* wl = a.ws + WS_W + (size_t)l * WL_STRIDE;
#pragma unroll 1
        for (int f = 0; f < 2; ++f) {
            if (f == 1) {
                { pg8::Gemm g{XB, (const bf16*)(wl + WL_WIN), NTOK, IW, DM}; pg8::StaticOrder S; S.init(NTOK, IW, G, (int)blockIdx.x);
                  EpiWin E{HZ, SSQ, RC, RS, lds + OFF_SSQL};
                  pg8::gemm_phase<EpiWin, pg8::StaticOrder, true, true>(lds, g, S, E); }
                if (G == 256 && blockIdx.x >= 192) tail_convert(a, l + 1, 128 + (int)blockIdx.x - 192, lds);
                GRID_BAR();
                for (int it = blockIdx.x; it < 768; it += G) { PH_IDS
                    const int bx = it & 255, s = it >> 8, xq = bx & 7, jq = bx >> 3;
                    if (it < 256) { const int tile = (G == 256) ? xq * 32 + jq : it; s5_m1(a, l, tile, lds, tid, lane, wave); lru_tile<false>(a, l, tile, lds, tid, lane, wave); }
                    else { const int q = jq + 32 * (s - 1); const int unit = (G == 256) ? (((xq >> 2) * 4 + (q & 3)) * 64 + (xq & 3) * 16 + (q >> 2)) : it - 256; ret_kv(a, unit, lds, tid, lane, wave); }
                }
                GRID_BAR();
                { PH_IDS m2_scans(a, l, tid, G); }
                GRID_BAR();
                for (int it0 = blockIdx.x; it0 < 256; it0 += G) {
                    const int it = (G == 256) ? (it0 & 7) * 32 + (it0 >> 3) : it0;
                    { PH_IDS ret_out(a, it, lds, tid, lane, wave); }
                    { PH_IDS s5_m3(a, l, it, lds, tid, lane, wave); }
                    { PH_IDS lru_tile<true>(a, l, it, lds, tid, lane, wave); }
                }
                GRID_BAR();
                { pg8::Gemm g{Y, (const bf16*)(wl + WL_WOUT), NTOK, DM, DM}; pg8::StaticOrder S; S.init(NTOK, DM, G, (int)blockIdx.x);
                  EpiRes E{XB, SSQ, 1.0f, 1.0f};
                  pg8::gemm_phase<EpiRes, pg8::StaticOrder, true, true>(lds, g, S, E); }
                GRID_BAR();
            }
            { pg8::Gemm g{XB, (const bf16*)(wl + (f ? WL_GU2 : WL_GU1)), NTOK, 2 * FF, DM}; pg8::StaticOrder S; S.init(NTOK, 2 * FF, G, (int)blockIdx.x);
              EpiGU E{HZ, SSQ, lds + OFF_SSQL};
              pg8::gemm_phase<EpiGU, pg8::StaticOrder, true, true>(lds, g, S, E); }
            if (G == 256 && blockIdx.x >= 128) tail_convert(a, l + 1, f * 192 + (int)blockIdx.x - 128, lds);
            GRID_BAR();
            { pg8::Gemm g{HZ, (const bf16*)(wl + (f ? WL_D2 : WL_D1)), NTOK, DM, FF}; pg8::StaticOrder S; S.init(NTOK, DM, G, (int)blockIdx.x);
              EpiRes E{XB, SSQ, 0.5f, 2.0f};
              pg8::gemm_phase<EpiRes, pg8::StaticOrder, true, true>(lds, g, S, E); }
            GRID_BAR();
        }
    }
    { PH_IDS
        const int gw = blockIdx.x * NWAVE + wave, NGW = G * NWAVE; const float* fn = a.in[32];
        for (int m = gw; m < NTOK; m += NGW) {
            const u32x2* xr = (const u32x2*)(XB + (size_t)m * DM) + lane; f32x4* orow = (f32x4*)(a.out + (size_t)m * DM) + lane; f32x4 v[4]; float s = 0.f;
#pragma unroll
            for (int j = 0; j < 4; ++j) { const u32x2 r = xr[64 * j]; v[j] = (f32x4){__uint_as_float(r.x << 16), __uint_as_float(r.x & 0xffff0000u), __uint_as_float(r.y << 16), __uint_as_float(r.y & 0xffff0000u)};
                s += (v[j].x * v[j].x + v[j].y * v[j].y) + (v[j].z * v[j].z + v[j].w * v[j].w); }
            const float rstd = rsqrtf(wave_sum(s) * (1.0f / DM) + EPS);
#pragma unroll
            for (int j = 0; j < 4; ++j) { const f32x4 gn = *((const f32x4*)fn + lane + 64 * j); orow[64 * j] = v[j] * rstd * gn; }
        }
    }
}

extern "C" void kernel_launch(void* const* d_in, const int* in_sizes, int n_in, void* d_out, int out_size, void* d_ws, size_t ws_size, hipStream_t stream) {
    static int grid = 0;
    if (grid == 0) {
        if (n_in != 33 || in_sizes[0] != NTOK * DM || out_size != NTOK * DM || ws_size < WS_END) { fprintf(stderr, "kernel_launch: unexpected shapes (n_in %d, in0 %d, out %d, ws %zu < %zu)\n", n_in, n_in > 0 ? in_sizes[0] : -1, out_size, ws_size, (size_t)WS_END); grid = -1; return; }
        int dev = 0, cus = 0, per_cu = 0;
        hipGetDevice(&dev); hipDeviceGetAttribute(&cus, hipDeviceAttributeMultiprocessorCount, dev);
        if (hipFuncSetAttribute((const void*)fwd_kernel, hipFuncAttributeMaxDynamicSharedMemorySize, LDS_BYTES) != hipSuccess) { fprintf(stderr, "kernel_launch: hipFuncSetAttribute failed\n"); grid = -1; return; }
        if (hipOccupancyMaxActiveBlocksPerMultiprocessor(&per_cu, (const void*)fwd_kernel, NTHR, LDS_BYTES) != hipSuccess || per_cu < 1) { fprintf(stderr, "kernel_launch: occupancy query says %d\n", per_cu); per_cu = 1; }
        (void)hipGetLastError();
        grid = cus * 1;
    }
    if (grid < 0) return;
    Args a{};
    for (int i = 0; i < 33; ++i) a.in[i] = (const float*)d_in[i];
    a.out = (float*)d_out; a.ws = (unsigned char*)d_ws;
    if (hipMemsetAsync((char*)d_ws + WS_CTL, 0, 65536, stream) != hipSuccess) { fprintf(stderr, "kernel_launch: memset failed\n"); return; }
    void* args[] = {&a};
    hipError_t e = hipLaunchCooperativeKernel((const void*)fwd_kernel, dim3(grid), dim3(NTHR), args, LDS_BYTES, stream);
    if (e != hipSuccess) fprintf(stderr, "kernel_launch: cooperative launch failed: %s (grid %d)\n", hipGetErrorString(e), grid);
}
```

```cpp
#include <hip/hip_runtime.h>
#include <hip/hip_cooperative_groups.h>
#include <cstdio>
#include <cstdint>
namespace cg = cooperative_groups;
namespace pg8 {
#define PG8_LAS __attribute__((address_space(3)))
typedef unsigned short bf16_t;
typedef short bf16x8 __attribute__((ext_vector_type(8)));
typedef float f32x4 __attribute__((ext_vector_type(4)));
typedef unsigned u32x4 __attribute__((ext_vector_type(4)));
constexpr int BM = 256, BK = 64, HALF = 128, HTB = HALF * BK * 2  , STAGE_BYTES = 8 * HTB, NXCD = 8, WGM = 4;

__host__ __device__ __forceinline__ int lds_byte(int r, int c) { const int st = (r >> 4) * 2 + (c >> 5), rr = r & 15, cc = c & 31, ob = rr * 64 + cc * 2; return st * 1024 + (ob ^ (((ob >> 9) & 1) << 5)); }
__host__ __device__ __forceinline__ void stage_rc(int b, int& R, int& C) { const int st = b / 1024, sb = b % 1024, swz = sb ^ (((sb >> 9) & 1) << 5); R = (st >> 1) * 16 + swz / 64; C = (st & 1) * 32 + (swz % 64) / 2; }
__host__ __device__ __forceinline__ int perm32(int rho) { const int n = rho >> 4, i = rho & 15; return 8 * (i >> 2) + 4 * n + (i & 3); }

struct Unit { int pm, pn; };
struct Gemm { const bf16_t* A; const bf16_t* Bt; int M, N, K; };

struct StaticOrder {
    int nM, nN, nwg, G, c;
    __host__ __device__ void init(int M, int N, int G_, int c_) { nM = M / BM; nN = N / BM; nwg = nM * nN; G = G_; c = c_; }
    __host__ __device__ bool next(int i, Unit& u) const {
        const long L = (long)i * G + c; if (L >= nwg) return false;
        int wgid = (int)L; { const int q = nwg / NXCD, r = nwg % NXCD, xcd = wgid % NXCD, off = wgid / NXCD; wgid = (xcd < r ? xcd * (q + 1) : r * (q + 1) + (xcd - r) * q) + off; }
        const int nig = WGM * nN, gid = wgid / nig, fm = gid * WGM, gsz = (nM - fm) < WGM ? (nM - fm) : WGM;
        u.pm = fm + ((wgid % nig) % gsz); u.pn = (wgid % nig) / gsz; return true;
    }
    __device__ __forceinline__ void a_ready(const Unit&) const {}
    __device__ __forceinline__ void done(const Unit&) const {}
};

__device__ __forceinline__ unsigned cvt_pk_bf16(float lo, float hi) { unsigned r; asm volatile("v_cvt_pk_bf16_f32 %0, %1, %2" : "=v"(r) : "v"(lo), "v"(hi)); return r; }
template <class Epi, class Sched, bool ALIGN_EPI = false, bool SP2 = false>
__device__ __forceinline__ void gemm_phase(PG8_LAS unsigned char* lds, const Gemm g, const Sched& S, const Epi& E) {
    int tid_ = threadIdx.x; asm volatile("" : "+v"(tid_)); const int tid = tid_, wid = __builtin_amdgcn_readfirstlane(tid >> 6), lane = tid & 63, wr = wid >> 2, wc = wid & 3, fr = lane & 15, fq = lane >> 4;
    const int K = g.K, nt = K / BK;
    unsigned voffA[2], voffB[2];
#pragma unroll
    for (int i = 0; i < 2; ++i) { int R, C; stage_rc(tid * 16 + i * 8192, R, C); const int Rb = Epi::PERM ? ((R & ~31) + perm32(R & 31)) : R;
        voffA[i] = (unsigned)(R * K + C) * 2u; voffB[i] = (unsigned)(Rb * K + C) * 2u; }
    const size_t kstep = (size_t)(BK * 2);
    const size_t hstep = (size_t)HALF * K * 2;
    const size_t tstep = 2 * hstep;
    const unsigned ldsw = (unsigned)wid * 1024u;
    const int aoff = lds_byte(wr * 64 + fr, fq * 8), boff = lds_byte(wc * 32 + fr, fq * 8);
#define PG8_SA(b, h) (((b) * 2 + (h)) * HTB)
#define PG8_SB(b, h) ((4 + (b) * 2 + (h)) * HTB)
#define PG8_STAGE(bufoff, gbase, voff) do { _Pragma("unroll") for (int _i = 0; _i < 2; ++_i) \
        __builtin_amdgcn_global_load_lds((const unsigned*)((const char*)(gbase) + (voff)[_i]), (PG8_LAS unsigned*)(lds + (bufoff) + ldsw + _i * 8192), 16, 0, 0); } while (0)
#define PG8_LDA(dst, b, h) do { _Pragma("unroll") for (int m = 0; m < 4; ++m) _Pragma("unroll") for (int k = 0; k < 2; ++k) dst[m][k] = *(const PG8_LAS bf16x8*)(lds + PG8_SA(b, h) + aoff + m * 2048 + k * 1024); } while (0)
#define PG8_LDB(dst, b, h) do { _Pragma("unroll") for (int n = 0; n < 2; ++n) _Pragma("unroll") for (int k = 0; k < 2; ++k) dst[n][k] = *(const PG8_LAS bf16x8*)(lds + PG8_SB(b, h) + boff + n * 2048 + k * 1024); } while (0)
#define PG8_MMA(ai, bj, At, Bt) do { __builtin_amdgcn_s_setprio(1); _Pragma("unroll") for (int m = 0; m < 4; ++m) _Pragma("unroll") for (int n = 0; n < 2; ++n) _Pragma("unroll") for (int k = 0; k < 2; ++k) \
        acc[ai][bj][m][n] = __builtin_amdgcn_mfma_f32_16x16x32_bf16(Bt[n][k], At[m][k], acc[ai][bj][m][n], 0, 0, 0); __builtin_amdgcn_s_setprio(0); } while (0)
#define PG8_WAIT_V(n) asm volatile("s_waitcnt vmcnt(" #n ")" ::: "memory")
#define PG8_WAIT_L(n) asm volatile("s_waitcnt lgkmcnt(" #n ")" ::: "memory")
#define PG8_BAR __builtin_amdgcn_s_barrier()
#define PG8_SCHED __builtin_amdgcn_sched_barrier(0)
    Unit cur, nxt; int ui = 0;
    if (!S.next(0, cur)) return;
    f32x4 acc[2][2][4][2];
    typename Epi::Pre pre0 = E.issue(cur, wr, wc, fr, fq);
    bf16x8 At[4][2], B0[2][2], B1[2][2];
    const char* cA = (const char*)g.A + (size_t)cur.pm * tstep; const char* cB = (const char*)g.Bt + (size_t)cur.pn * tstep;
    S.a_ready(cur);
    if constexpr (SP2) {
        PG8_STAGE(PG8_SB(0, 0), cB, voffB); PG8_STAGE(PG8_SB(0, 1), cB + hstep, voffB); PG8_STAGE(PG8_SA(0, 0), cA, voffA); PG8_STAGE(PG8_SA(0, 1), cA + hstep, voffA);
        if (wr == 1) PG8_BAR;
        PG8_WAIT_V(2); PG8_BAR;
        PG8_STAGE(PG8_SB(1, 0), cB + kstep, voffB); PG8_STAGE(PG8_SA(1, 0), cA + kstep, voffA); PG8_STAGE(PG8_SB(1, 1), cB + hstep + kstep, voffB);
        PG8_WAIT_V(6); PG8_BAR;
    } else {
        PG8_STAGE(PG8_SB(0, 0), cB, voffB); PG8_STAGE(PG8_SA(0, 0), cA, voffA); PG8_STAGE(PG8_SB(0, 1), cB + hstep, voffB); PG8_STAGE(PG8_SA(0, 1), cA + hstep, voffA);
        if (wr == 1) PG8_BAR;
        PG8_WAIT_V(4); PG8_BAR;
        PG8_STAGE(PG8_SB(1, 0), cB + kstep, voffB); PG8_STAGE(PG8_SA(1, 0), cA + kstep, voffA); PG8_STAGE(PG8_SB(1, 1), cB + hstep + kstep, voffB);
        PG8_WAIT_V(6); PG8_BAR;
    }
    PG8_SCHED; E.finish(acc, pre0); PG8_SCHED;
    for (;;) {
        const bool has_next = S.next(ui + 1, nxt);
        const char* nA = has_next ? (const char*)g.A + (size_t)nxt.pm * tstep : cA; const char* nB = has_next ? (const char*)g.Bt + (size_t)nxt.pn * tstep : cB;
        for (int t = 0; t < nt; t += 2) {
            const bool last = (t == nt - 2);
            const char* a1 = cA + (size_t)(t + 1) * kstep;
            const char* a2 = last ? nA : cA + (size_t)(t + 2) * kstep; const char* b2 = last ? nB : cB + (size_t)(t + 2) * kstep;
            const char* a3 = a2 + kstep; const char* b3 = b2 + kstep;
            if (last && has_next) S.a_ready(nxt);
            if (last) E.pre(cur, wid, lane);
            if constexpr (SP2) {
            PG8_LDB(B0, 0, 0); PG8_LDB(B1, 0, 1); PG8_SCHED; PG8_LDA(At, 0, 0); PG8_STAGE(PG8_SA(1, 1), a1 + hstep, voffA);
            PG8_WAIT_V(8); PG8_WAIT_L(0); PG8_BAR; PG8_MMA(0, 0, At, B0); PG8_MMA(0, 1, At, B1); PG8_BAR; PG8_SCHED;
            PG8_LDA(At, 0, 1); PG8_STAGE(PG8_SB(0, 0), b2, voffB); PG8_STAGE(PG8_SB(0, 1), b2 + hstep, voffB); PG8_STAGE(PG8_SA(0, 0), a2, voffA);
            PG8_WAIT_V(8); PG8_WAIT_L(0); PG8_BAR; PG8_MMA(1, 0, At, B0); PG8_MMA(1, 1, At, B1); PG8_BAR; PG8_SCHED;
            PG8_LDB(B0, 1, 0); PG8_LDB(B1, 1, 1); PG8_SCHED; PG8_LDA(At, 1, 0); PG8_STAGE(PG8_SA(0, 1), a2 + hstep, voffA);
            PG8_WAIT_V(8); PG8_WAIT_L(0); PG8_BAR; PG8_MMA(0, 0, At, B0); PG8_MMA(0, 1, At, B1); PG8_BAR; PG8_SCHED;
            PG8_LDA(At, 1, 1); PG8_STAGE(PG8_SB(1, 0), b3, voffB); PG8_STAGE(PG8_SB(1, 1), b3 + hstep, voffB); PG8_STAGE(PG8_SA(1, 0), a3, voffA);
            PG8_WAIT_V(8); PG8_WAIT_L(0); PG8_BAR; PG8_MMA(1, 0, At, B0); PG8_MMA(1, 1, At, B1); PG8_BAR; PG8_SCHED;
            } else {
            PG8_LDB(B0, 0, 0); PG8_SCHED; PG8_LDA(At, 0, 0); PG8_STAGE(PG8_SA(1, 1), a1 + hstep, voffA);
            PG8_WAIT_L(8); PG8_BAR; PG8_WAIT_L(0); PG8_MMA(0, 0, At, B0); PG8_BAR; PG8_SCHED;
            PG8_LDB(B1, 0, 1); PG8_STAGE(PG8_SB(0, 0), b2, voffB);
            PG8_BAR; PG8_WAIT_L(0); PG8_MMA(0, 1, At, B1); PG8_BAR;
            PG8_LDA(At, 0, 1); PG8_STAGE(PG8_SA(0, 0), a2, voffA);
            PG8_BAR; PG8_WAIT_L(0); PG8_MMA(1, 0, At, B0); PG8_BAR; PG8_SCHED;
            PG8_STAGE(PG8_SB(0, 1), b2 + hstep, voffB);
            PG8_WAIT_V(6); PG8_BAR; PG8_MMA(1, 1, At, B1); PG8_BAR;
            PG8_LDB(B0, 1, 0); PG8_SCHED; PG8_LDA(At, 1, 0); PG8_STAGE(PG8_SA(0, 1), a2 + hstep, voffA);
            PG8_WAIT_L(8); PG8_BAR; PG8_WAIT_L(0); PG8_MMA(0, 0, At, B0); PG8_BAR; PG8_SCHED;
            PG8_LDB(B1, 1, 1); PG8_STAGE(PG8_SB(1, 0), b3, voffB);
            PG8_BAR; PG8_WAIT_L(0); PG8_MMA(0, 1, At, B1); PG8_BAR;
            PG8_LDA(At, 1, 1); PG8_STAGE(PG8_SA(1, 0), a3, voffA);
            PG8_BAR; PG8_WAIT_L(0); PG8_MMA(1, 0, At, B0); PG8_BAR; PG8_SCHED;
            PG8_STAGE(PG8_SB(1, 1), b3 + hstep, voffB);
            PG8_WAIT_V(6); PG8_BAR; PG8_MMA(1, 1, At, B1); PG8_BAR;
            }
        }
        if constexpr (ALIGN_EPI) { if (wr == 0) PG8_BAR; }
        if constexpr (!Epi::AFTER_DRAIN) { E(acc, cur, wr, wc, fr, fq); S.done(cur); }
        if (!has_next) break;
        { typename Epi::Pre pren = E.issue(nxt, wr, wc, fr, fq); E.finish(acc, pren); }
        cur = nxt; cA = nA; cB = nB; ++ui;
        if constexpr (ALIGN_EPI) { if (wr == 1) PG8_BAR; }
    }
    PG8_WAIT_V(0);
    if constexpr (!ALIGN_EPI) { if (wr == 0) PG8_BAR; }
    PG8_BAR;
    if constexpr (Epi::AFTER_DRAIN) { E.fused(acc, cur, wr, wc, fr, fq, lds, wid, lane); S.done(cur); }
#undef PG8_SA
#undef PG8_SB
#undef PG8_STAGE
#undef PG8_LDA
#undef PG8_LDB
#undef PG8_MMA
#undef PG8_WAIT_V
#undef PG8_WAIT_L
#undef PG8_BAR
#undef PG8_SCHED
}
}

#define LAS __attribute__((address_space(3)))
typedef unsigned short bf16;
typedef float f32x4 __attribute__((ext_vector_type(4)));
typedef float f32x2 __attribute__((ext_vector_type(2)));
typedef short bf16x8 __attribute__((ext_vector_type(8)));
typedef unsigned u32x4 __attribute__((ext_vector_type(4)));
typedef unsigned u32x2 __attribute__((ext_vector_type(2)));

constexpr int NTOK = 16384, SEQ = 8192, DM = 1024, FF = 2816, IW = 2816, NL = 4;
constexpr float EPS = 1e-6f;
constexpr int NTHR = 512, NWAVE = 8;
constexpr int LDS_BYTES = 155648;
constexpr int OFF_SSQL = 131072;

constexpr size_t MiB = 1u << 20;
constexpr size_t WS_CTL = 0;
constexpr size_t WS_ROPE = 1 * MiB;
constexpr size_t WS_SSQ = 5 * MiB;
constexpr size_t WS_S5E = 6 * MiB;
constexpr size_t WS_LRUC = 8 * MiB;
constexpr size_t WS_TAB = 9 * MiB;
constexpr size_t WS_W = 10 * MiB;
constexpr size_t WL_STRIDE = 43 * MiB;
constexpr size_t WL_GU1 = 0, WL_D1 = 11534336, WL_WIN = WL_D1 + 5767168, WL_WOUT = WL_WIN + 5767168, WL_GU2 = WL_WOUT + 2097152,
                 WL_D2 = WL_GU2 + 11534336, WL_GLU = WL_D2 + 5767168, WL_WA = WL_GLU + 131072, WL_WX = WL_WA + 32768, WL_CM = WL_WX + 32768,
                 WL_S5T = WL_CM + 65536, WL_BB = WL_S5T + 147456, WL_END = WL_BB + 65536;
static_assert(WL_END <= WL_STRIDE, "weights per layer");
constexpr size_t WS_XB = 182 * MiB;
constexpr size_t WS_HZ = 214 * MiB;
constexpr size_t WS_Y = 302 * MiB;
constexpr size_t WS_KV = 334 * MiB;
constexpr size_t WS_PB = 366 * MiB;
constexpr size_t WS_END = 382 * MiB;

struct Args { const float* in[33]; float* out; unsigned char* ws; };

#define XB_TMO      128
#define XB_XCNT(j)  (256  + 64 * (j))
#define XB_XSUB(j)  (1280 + 64 * (j))
#define XB_XGEN(j)  (2304 + 64 * (j))
#define XB_TOP      3328
#define XB_TOPGEN   3392
#define XCD_BAR_WORDS 3456
#define XB_SPIN_CAP (1u << 18)

__device__ __forceinline__ unsigned xb_ld(unsigned* p)              { return __hip_atomic_load(p, __ATOMIC_RELAXED, __HIP_MEMORY_SCOPE_AGENT); }
__device__ __forceinline__ unsigned xb_add(unsigned* p, unsigned v) { return __hip_atomic_fetch_add(p, v, __ATOMIC_RELAXED, __HIP_MEMORY_SCOPE_AGENT); }
__device__ __forceinline__ unsigned xb_xcc_id() { return (unsigned)__builtin_amdgcn_s_getreg((3 << 11) | 20) & 0xFu; }
#define XB_SPIN(cond, bar) do { unsigned _sp = 0; while (cond) { __builtin_amdgcn_s_sleep(1); \
    if ((++_sp & 255u) == 0u) { if (xb_ld(&(bar)[XB_TMO])) break; if (_sp > XB_SPIN_CAP) { atomicAdd(&(bar)[XB_TMO], 1u); break; } } } } while (0)

struct XcdBarrier {
    unsigned* bar; unsigned x;
    volatile LAS unsigned* st;
};

__device__ __forceinline__ XcdBarrier xcd_barrier_post(unsigned* bar, volatile LAS unsigned* st) {
    XcdBarrier b; b.bar = bar; b.x = xb_xcc_id(); b.st = st;
    if (threadIdx.x == 0) (void)xb_add(&bar[XB_XCNT(b.x)], 1u);
    return b;
}
__device__ __forceinline__ void xcd_barrier_complete(unsigned* bar, unsigned x, unsigned& nloc, unsigned& nx) {
    const unsigned G = gridDim.x * gridDim.y * gridDim.z;
    unsigned sum, cnt, mine, sp = 0u;
    for (;;) {
        sum = 0u; cnt = 0u; mine = 0u;
#pragma unroll
        for (unsigned j = 0; j < 16; ++j) { const unsigned c = xb_ld(&bar[XB_XCNT(j)]); sum += c; cnt += (c > 0u) ? 1u : 0u; mine = (j == x) ? c : mine; }
        if (sum == G) break;
        __builtin_amdgcn_s_sleep(1);
        if ((++sp & 255u) == 0u) { if (xb_ld(&bar[XB_TMO])) break; if (sp > XB_SPIN_CAP) { atomicAdd(&bar[XB_TMO], 1u); break; } }
    }
    nloc = mine > 0u ? mine : 1u; nx = cnt > 0u ? cnt : 1u;
}

__device__ __forceinline__ void xcd_barrier(const XcdBarrier& b) {
    asm volatile("s_waitcnt vmcnt(0)" ::: "memory");
    __syncthreads();
    if (threadIdx.x == 0) {
        unsigned* bar = b.bar;
        __builtin_amdgcn_s_waitcnt(0);
        unsigned nloc = b.st[0], nx = b.st[1];
        if (nloc == 0u) { xcd_barrier_complete(bar, b.x, nloc, nx); b.st[0] = nloc; b.st[1] = nx; }
        const unsigned old = xb_add(&bar[XB_XSUB(b.x)], 1u);
        const unsigned gen = old / nloc;
        if (old + 1u == (gen + 1u) * nloc) {
            __builtin_amdgcn_fence(__ATOMIC_RELEASE, "agent");
            asm volatile("s_waitcnt vmcnt(0)" ::: "memory");
            const unsigned og = xb_add(&bar[XB_TOP], 1u);
            const unsigned tg = og / nx;
            if (og + 1u == (tg + 1u) * nx) xb_add(&bar[XB_TOPGEN], 1u);
            else XB_SPIN(xb_ld(&bar[XB_TOPGEN]) == tg, bar);
            __builtin_amdgcn_fence(__ATOMIC_ACQUIRE, "agent");
            xb_add(&bar[XB_XGEN(b.x)], 1u);
            asm volatile("s_waitcnt vmcnt(0)" ::: "memory");
        } else {
            XB_SPIN(xb_ld(&bar[XB_XGEN(b.x)]) == gen, bar);
            __builtin_amdgcn_fence(__ATOMIC_ACQUIRE, "agent");
            asm volatile("s_waitcnt vmcnt(0)" ::: "memory");
        }
    }
    __syncthreads();
}

constexpr int MISC_OFF = LDS_BYTES - 64;
constexpr int CW_BAR = 4096;

__device__ __forceinline__ float bf2f(unsigned v) { return __uint_as_float(v << 16); }
__device__ __forceinline__ unsigned pk2(float lo, float hi) { return pg8::cvt_pk_bf16(lo, hi); }
__device__ __forceinline__ float sigmoidf_(float x) { return __builtin_amdgcn_rcpf(1.0f + __expf(-x)); }
__device__ __forceinline__ float siluf_(float x) { return x * sigmoidf_(x); }
__device__ __forceinline__ float geluf_(float x) { const float z = 1.5957691216057308f * (x + 0.044715f * x * x * x); return x * sigmoidf_(z); }
__device__ __forceinline__ void lds_wait() { asm volatile("s_waitcnt lgkmcnt(0)" ::: "memory"); }
__device__ __forceinline__ void unpack8(u32x4 v, float* f) {
    f[0] = __uint_as_float(v.x << 16); f[1] = __uint_as_float(v.x & 0xffff0000u); f[2] = __uint_as_float(v.y << 16); f[3] = __uint_as_float(v.y & 0xffff0000u);
    f[4] = __uint_as_float(v.z << 16); f[5] = __uint_as_float(v.z & 0xffff0000u); f[6] = __uint_as_float(v.w << 16); f[7] = __uint_as_float(v.w & 0xffff0000u);
}
__device__ __forceinline__ float row_rstd(const float* ssq, int row) {
    const f32x4* p = (const f32x4*)(ssq + (size_t)row * 16);
    const f32x4 a = p[0], b = p[1], c = p[2], d = p[3];
    const float s = ((a.x + a.y) + (a.z + a.w)) + ((b.x + b.y) + (b.z + b.w)) + ((c.x + c.y) + (c.z + c.w)) + ((d.x + d.y) + (d.z + d.w));
    return rsqrtf(s * (1.0f / DM) + EPS);
}
__device__ __forceinline__ void rows_rstd(LAS unsigned char* sl, int rl0, int fq, float (&rs)[8]) {
    f32x4 v[8];
#pragma unroll
    for (int i = 0; i < 8; ++i) v[i] = *(const LAS f32x4*)(sl + (rl0 + (i >> 2) * 128 + (i & 3) * 16) * 64 + fq * 16);
#pragma unroll
    for (int i = 0; i < 8; ++i) { float s = (v[i].x + v[i].y) + (v[i].z + v[i].w); s += __shfl_xor(s, 16); s += __shfl_xor(s, 32); rs[i] = rsqrtf(s * (1.0f / DM) + EPS); }
}
#define MFMA16(X, Y, ACC) ACC = __builtin_amdgcn_mfma_f32_16x16x32_bf16(X, Y, ACC, 0, 0, 0)

struct EpiGU {
    static constexpr bool PERM = true, AFTER_DRAIN = false;
    bf16* H; const float* ssq;
    struct Pre {};
    __device__ __forceinline__ Pre issue(const pg8::Unit&, int, int, int, int) const { return Pre{}; }
    __device__ __forceinline__ void finish(f32x4 (&acc)[2][2][4][2], const Pre&) const {
#pragma unroll
        for (int a = 0; a < 2; ++a)
#pragma unroll
            for (int b = 0; b < 2; ++b)
#pragma unroll
                for (int m = 0; m < 4; ++m)
#pragma unroll
                    for (int n = 0; n < 2; ++n) acc[a][b][m][n] = (f32x4){0.f, 0.f, 0.f, 0.f};
    }
    LAS unsigned char* sl;
    __device__ __forceinline__ void pre(const pg8::Unit& u, int wid, int lane) const {
#pragma unroll
        for (int i = 0; i < 2; ++i) __builtin_amdgcn_global_load_lds((const unsigned*)(ssq + (size_t)(u.pm * 256 + wid * 32 + i * 16 + (lane >> 2)) * 16 + (lane & 3) * 4), (LAS unsigned*)(sl + (wid * 32 + i * 16) * 64), 16, 0, 0);
    }
    __device__ __forceinline__ void operator()(const f32x4 (&acc)[2][2][4][2], const pg8::Unit& u, int wr, int wc, int fr, int fq) const {
        const int row0 = u.pm * 256 + wr * 64 + fr, col0 = u.pn * 128 + wc * 32 + 8 * fq;
        float rs[8]; rows_rstd(sl, wr * 64 + fr, fq, rs);
#pragma unroll
        for (int ai = 0; ai < 2; ++ai)
#pragma unroll
            for (int m = 0; m < 4; ++m) {
                const int row = row0 + ai * 128 + m * 16; const float r = rs[ai * 4 + m];
                float h[8];
#pragma unroll
                for (int n = 0; n < 2; ++n)
#pragma unroll
                    for (int j = 0; j < 4; ++j) { const float g = acc[ai][0][m][n][j] * r, up = acc[ai][1][m][n][j] * r; h[n * 4 + j] = siluf_(g) * up; }
                u32x4 w; w.x = pk2(h[0], h[1]); w.y = pk2(h[2], h[3]); w.z = pk2(h[4], h[5]); w.w = pk2(h[6], h[7]);
                *(u32x4*)(H + (size_t)row * FF + col0) = w;
            }
    }
};
struct EpiRes {
    static constexpr bool PERM = true, AFTER_DRAIN = false;
    bf16* XB; float* ssq; float alpha, inv_alpha;
    struct Pre { u32x4 v[2][4][2]; };
    __device__ __forceinline__ void pre(const pg8::Unit&, int, int) const {}
    __device__ __forceinline__ Pre issue(const pg8::Unit& u, int wr, int wc, int fr, int fq) const {
        Pre p; const int row0 = u.pm * 256 + wr * 64 + fr, colb = u.pn * 256 + wc * 32 + 8 * fq;
#pragma unroll
        for (int ai = 0; ai < 2; ++ai)
#pragma unroll
            for (int m = 0; m < 4; ++m)
#pragma unroll
                for (int bj = 0; bj < 2; ++bj) p.v[ai][m][bj] = *(const u32x4*)(XB + (size_t)(row0 + ai * 128 + m * 16) * DM + colb + bj * 128);
        return p;
    }
    __device__ __forceinline__ void finish(f32x4 (&acc)[2][2][4][2], const Pre& p) const {
#pragma unroll
        for (int ai = 0; ai < 2; ++ai)
#pragma unroll
            for (int m = 0; m < 4; ++m)
#pragma unroll
                for (int bj = 0; bj < 2; ++bj) { float f[8]; unpack8(p.v[ai][m][bj], f);
                    acc[ai][bj][m][0] = (f32x4){f[0], f[1], f[2], f[3]} * inv_alpha; acc[ai][bj][m][1] = (f32x4){f[4], f[5], f[6], f[7]} * inv_alpha; }
    }
    __device__ __forceinline__ void operator()(const f32x4 (&acc)[2][2][4][2], const pg8::Unit& u, int wr, int wc, int fr, int fq) const {
        const int row0 = u.pm * 256 + wr * 64 + fr, colb = u.pn * 256 + wc * 32 + 8 * fq;
#pragma unroll
        for (int ai = 0; ai < 2; ++ai)
#pragma unroll
            for (int m = 0; m < 4; ++m) {
                const int row = row0 + ai * 128 + m * 16;
                float ss = 0.f;
#pragma unroll
                for (int bj = 0; bj < 2; ++bj) {
                    const f32x4 x0 = acc[ai][bj][m][0] * alpha, x1 = acc[ai][bj][m][1] * alpha;
                    u32x4 w; w.x = pk2(x0.x, x0.y); w.y = pk2(x0.z, x0.w); w.z = pk2(x1.x, x1.y); w.w = pk2(x1.z, x1.w);
                    *(u32x4*)(XB + (size_t)row * DM + colb + bj * 128) = w;
                    ss += (x0.x * x0.x + x0.y * x0.y) + (x0.z * x0.z + x0.w * x0.w) + (x1.x * x1.x + x1.y * x1.y) + (x1.z * x1.z + x1.w * x1.w);
                }
                ss += __shfl_xor(ss, 16); ss += __shfl_xor(ss, 32);
                if (fq == 0) ssq[(size_t)row * 16 + u.pn * 4 + wc] = ss;
            }
    }
};
struct EpiWin {
    static constexpr bool PERM = true, AFTER_DRAIN = false;
    bf16* Z; const float* ssq; const float* rcos; const float* rsin;
    struct Pre {};
    __device__ __forceinline__ Pre issue(const pg8::Unit&, int, int, int, int) const { return Pre{}; }
    __device__ __forceinline__ void finish(f32x4 (&acc)[2][2][4][2], const Pre&) const {
#pragma unroll
        for (int a = 0; a < 2; ++a)
#pragma unroll
            for (int b = 0; b < 2; ++b)
#pragma unroll
                for (int m = 0; m < 4; ++m)
#pragma unroll
                    for (int n = 0; n < 2; ++n) acc[a][b][m][n] = (f32x4){0.f, 0.f, 0.f, 0.f};
    }
    LAS unsigned char* sl;
    __device__ __forceinline__ void pre(const pg8::Unit& u, int wid, int lane) const {
#pragma unroll
        for (int i = 0; i < 2; ++i) __builtin_amdgcn_global_load_lds((const unsigned*)(ssq + (size_t)(u.pm * 256 + wid * 32 + i * 16 + (lane >> 2)) * 16 + (lane & 3) * 4), (LAS unsigned*)(sl + (wid * 32 + i * 16) * 64), 16, 0, 0);
    }
    __device__ __forceinline__ void operator()(const f32x4 (&acc)[2][2][4][2], const pg8::Unit& u, int wr, int wc, int fr, int fq) const {
        const int row0 = u.pm * 256 + wr * 64 + fr, pn = u.pn;
        float rs[8]; rows_rstd(sl, wr * 64 + fr, fq, rs);
        if (pn >= 1 && pn <= 4) {
            const float qs = (pn <= 2) ? 0.08838834764831845f : 1.0f;
            const int dd0 = 32 * (wc & 1) + 8 * fq, hh = wc >> 1;
#pragma unroll
            for (int ab = 0; ab < 4; ++ab) { const int ai = ab >> 1, mb = (ab & 1) * 2;
                f32x4 cs[4][4];
#pragma unroll
                for (int m = mb; m < mb + 2; ++m) { const int pos = (row0 + ai * 128 + m * 16) & (SEQ - 1); const float* cp = rcos + pos * 64 + dd0; const float* sp = rsin + pos * 64 + dd0;
                    cs[m][0] = *(const f32x4*)cp; cs[m][1] = *(const f32x4*)(cp + 4); cs[m][2] = *(const f32x4*)sp; cs[m][3] = *(const f32x4*)(sp + 4); }
#pragma unroll
                for (int m = mb; m < mb + 2; ++m) {
                    const int row = row0 + ai * 128 + m * 16; const float r = rs[ai * 4 + m] * qs;
                    const f32x4 c0 = cs[m][0], c1 = cs[m][1], s0 = cs[m][2], s1 = cs[m][3];
                    const f32x4 ta = acc[ai][0][m][0] * r, tb = acc[ai][0][m][1] * r, ua = acc[ai][1][m][0] * r, ub = acc[ai][1][m][1] * r;
                    const f32x4 o1a = ta * c0 - ua * s0, o1b = tb * c1 - ub * s1, o2a = ta * s0 + ua * c0, o2b = tb * s1 + ub * c1;
                    bf16* zp = Z + (size_t)row * IW + pn * 256 + hh * 128 + dd0;
                    u32x4 w1, w2;
                    w1.x = pk2(o1a.x, o1a.y); w1.y = pk2(o1a.z, o1a.w); w1.z = pk2(o1b.x, o1b.y); w1.w = pk2(o1b.z, o1b.w);
                    w2.x = pk2(o2a.x, o2a.y); w2.y = pk2(o2a.z, o2a.w); w2.z = pk2(o2b.x, o2b.y); w2.w = pk2(o2b.z, o2b.w);
                    *(u32x4*)zp = w1; *(u32x4*)(zp + 64) = w2;
                }
                asm volatile("" ::: "memory");
            }
        } else {
            const int act = (pn == 7 || pn == 8) ? 1 : (pn == 10 ? 2 : 0);
#pragma unroll
            for (int ai = 0; ai < 2; ++ai)
#pragma unroll
                for (int m = 0; m < 4; ++m) {
                    const int row = row0 + ai * 128 + m * 16; const float r = rs[ai * 4 + m];
#pragma unroll
                    for (int bj = 0; bj < 2; ++bj) {
                        float v[8];
#pragma unroll
                        for (int n = 0; n < 2; ++n)
#pragma unroll
                            for (int j = 0; j < 4; ++j) { float t = acc[ai][bj][m][n][j] * r; if (act == 1) t = siluf_(t); else if (act == 2) t = geluf_(t); v[n * 4 + j] = t; }
                        u32x4 w; w.x = pk2(v[0], v[1]); w.y = pk2(v[2], v[3]); w.z = pk2(v[4], v[5]); w.w = pk2(v[6], v[7]);
                        *(u32x4*)(Z + (size_t)row * IW + pn * 256 + bj * 128 + wc * 32 + 8 * fq) = w;
                    }
                }
        }
    }
};

__device__ __forceinline__ void transpose_item(const float* W, int N, bf16* WT, int K, int k0, int n0, int drow0, const float* gk, LAS float* scr, int lane) {
    float wv[32];
#pragma unroll
    for (int i = 0; i < 32; ++i) wv[i] = W[(size_t)(k0 + 2 * i + (lane >> 5)) * N + n0 + (lane & 31)];
#pragma unroll
    for (int i = 0; i < 32; ++i) { const int kk = 2 * i + (lane >> 5); float v = wv[i]; if (gk) v *= gk[kk]; scr[kk * 33 + (lane & 31)] = v; }
    lds_wait();
    const int c = lane & 7;
#pragma unroll
    for (int j = 0; j < 4; ++j) { const int n = (lane >> 3) + 8 * j; const LAS float* s = scr + (8 * c) * 33 + n;
        u32x4 o; o.x = pk2(s[0 * 33], s[1 * 33]); o.y = pk2(s[2 * 33], s[3 * 33]); o.z = pk2(s[4 * 33], s[5 * 33]); o.w = pk2(s[6 * 33], s[7 * 33]);
        *(u32x4*)(WT + (size_t)(drow0 + n) * K + k0 + 8 * c) = o; }
    lds_wait();
}
constexpr int IT_BIG = 1408, IT_OUT = 512, IT_GLU = 32, IT_LW = 8;
constexpr int IT_LAYER = 7 * IT_BIG + IT_OUT + IT_GLU + 2 * IT_LW;
__device__ __forceinline__ void p0_weight_item(const Args& a, int l, int r, LAS float* scr, int lane) {
    unsigned char* wl = a.ws + WS_W + (size_t)l * WL_STRIDE;
#pragma unroll
    for (int f = 0; f < 2; ++f) {
        const float* nrm = a.in[f ? 28 : 1] + (size_t)l * DM;
        bf16* gu = (bf16*)(wl + (f ? WL_GU2 : WL_GU1)); bf16* dn = (bf16*)(wl + (f ? WL_D2 : WL_D1));
        if (r < 2 * IT_BIG) { const int up = r >= IT_BIG; const int it = r - up * IT_BIG; const int kb = it / 88, nb = it % 88, k0 = 64 * kb, n0 = 32 * nb;
            const float* W = a.in[(f ? 29 : 2) + up] + (size_t)l * DM * FF;
            transpose_item(W, FF, gu, DM, k0, n0, (n0 >> 7) * 256 + up * 128 + (n0 & 127), nrm + k0, scr, lane); return; }
        r -= 2 * IT_BIG;
        if (r < IT_BIG) { const int kb = r / 32, nb = r % 32; const float* W = a.in[f ? 31 : 4] + (size_t)l * FF * DM;
            transpose_item(W, DM, dn, FF, 64 * kb, 32 * nb, 32 * nb, nullptr, scr, lane); return; }
        r -= IT_BIG;
    }
    if (r < IT_BIG) {
        const int kb = r / 88, nb = r % 88, k0 = 64 * kb, n0 = 32 * nb; const int tile = n0 >> 8, c0 = n0 & 255;
        int drow = n0;
        if (tile >= 1 && tile <= 4) { const int hh = c0 >> 7, d0 = c0 & 127, bj = d0 >> 6, dd0 = d0 & 63; drow = tile * 256 + bj * 128 + hh * 64 + dd0; }
        transpose_item(a.in[6] + (size_t)l * DM * IW, IW, (bf16*)(wl + WL_WIN), DM, k0, n0, drow, a.in[5] + (size_t)l * DM + k0, scr, lane); return; }
    r -= IT_BIG;
    if (r < IT_OUT) {
        const int kb = r / 32, nb = r % 32, k0 = 64 * kb;
        const float* gk = (k0 < 256) ? a.in[17] + (size_t)l * 256 + k0 : (k0 < 768 ? a.in[18] + (size_t)l * 512 + (k0 - 256) : a.in[26] + (size_t)l * 256 + (k0 - 768));
        transpose_item(a.in[27] + (size_t)l * DM * DM, DM, (bf16*)(wl + WL_WOUT), DM, k0, 32 * nb, 32 * nb, gk, scr, lane); return; }
    r -= IT_OUT;
    if (r < IT_GLU) { const int kb = r / 8, nb = r % 8; transpose_item(a.in[15] + (size_t)l * 65536, 256, (bf16*)(wl + WL_GLU), 256, 64 * kb, 32 * nb, 32 * nb, nullptr, scr, lane); return; }
    r -= IT_GLU;
    if (r < IT_LW) { const int blk = r >> 1, nb = r & 1; transpose_item(a.in[21] + (size_t)l * 16384 + blk * 4096, 64, (bf16*)(wl + WL_WA) + blk * 4096, 64, 0, 32 * nb, 32 * nb, nullptr, scr, lane); return; }
    r -= IT_LW;
    { const int blk = r >> 1, nb = r & 1; transpose_item(a.in[23] + (size_t)l * 16384 + blk * 4096, 64, (bf16*)(wl + WL_WX) + blk * 4096, 64, 0, 32 * nb, 32 * nb, nullptr, scr, lane); }
}
__device__ __forceinline__ float wave_sum(float v) {
#pragma unroll
    for (int o = 1; o < 64; o <<= 1) v += __shfl_xor(v, o);
    return v;
}
__device__ __forceinline__ void p0_prologue(const Args& a, LAS unsigned char* lds, int tid, int lane, int wave, int G) {
    LAS float* scr = (LAS float*)(lds + wave * 8448);
    const int gw = blockIdx.x * NWAVE + wave, NGW = G * NWAVE;
    for (int it = gw; it < (G == 256 ? 1 : NL) * IT_LAYER; it += NGW) p0_weight_item(a, it / IT_LAYER, it % IT_LAYER, scr, lane);
    const float* x = a.in[0]; bf16* xb = (bf16*)(a.ws + WS_XB); float* ssq = (float*)(a.ws + WS_SSQ);
    for (int m = gw; m < NTOK; m += NGW) {
        const f32x4* xr = (const f32x4*)(x + (size_t)m * DM) + lane; u32x2* brow = (u32x2*)(xb + (size_t)m * DM) + lane;
        float s = 0.f;
#pragma unroll
        for (int j = 0; j < 4; ++j) { const f32x4 v = xr[64 * j]; u32x2 w; w.x = pk2(v.x, v.y); w.y = pk2(v.z, v.w); brow[64 * j] = w; s += (v.x * v.x + v.y * v.y) + (v.z * v.z + v.w * v.w); }
        s = wave_sum(s);
        if (lane < 16) ssq[(size_t)m * 16 + lane] = (lane == 0) ? s : 0.f;
    }
    const int gt = blockIdx.x * NTHR + tid, NGT = G * NTHR;
    float* rcos = (float*)(a.ws + WS_ROPE); float* rsin = rcos + SEQ * 64;
    for (int i = gt; i < SEQ * 64; i += NGT) { const int pos = i >> 6, k = i & 63; const float inv = powf(10000.0f, -(float)(2 * k) / 128.0f); const float ang = (float)pos * inv; rcos[i] = cosf(ang); rsin[i] = sinf(ang); }
    for (int i = gt; i < NL * 16 * 64; i += NGT) {
        const int p = i & 63, lg = i >> 6, l = lg >> 4, g = lg & 15;
        const float lre = a.in[7][i], lim = a.in[8][i], step = expf(a.in[9][lg]);
        const float ar = lre * step, ai = lim * step, mag = expf(ar), lbr = mag * cosf(ai), lbi = mag * sinf(ai);
        const float nr = lbr - 1.0f, den = lre * lre + lim * lim, fr = (nr * lre + lbi * lim) / den, fi = (lbi * lre - nr * lim) / den;
        float* tab = (float*)(a.ws + WS_W + (size_t)l * WL_STRIDE + WL_S5T) + (size_t)g * 36 * 64 + p;
        float cr = lbr, ci = lbi;
#pragma unroll
        for (int q = 0; q < 6; ++q) { const float t = cr * cr - ci * ci; ci = 2.0f * cr * ci; cr = t; }
        tab[0] = lbr; tab[64] = lbi; tab[128] = cr; tab[192] = ci;
        for (int h = 0; h < 16; ++h) { const float br = a.in[10][(size_t)i * 16 + h], bi = a.in[11][(size_t)i * 16 + h]; const float bbr = fr * br - fi * bi, bbi = fr * bi + fi * br; tab[(4 + h) * 64] = bbr; tab[(20 + h) * 64] = bbi;
            bf16* BB = (bf16*)(a.ws + WS_W + (size_t)l * WL_STRIDE + WL_BB); const unsigned pr = pk2(bbr, bbi);
            BB[(size_t)(g * 128 + p) * 16 + h] = (bf16)(pr & 0xffffu); BB[(size_t)(g * 128 + 64 + p) * 16 + h] = (bf16)(pr >> 16); }
    }
    for (int i = gt; i < NL * 16 * 16 * 128; i += NGT) {
        const int k = i & 127, lgh = i >> 7, l = lgh >> 8;
        const float v = (k < 64) ? a.in[12][(size_t)lgh * 64 + k] : -a.in[13][(size_t)lgh * 64 + (k - 64)];
        ((bf16*)(a.ws + WS_W + (size_t)l * WL_STRIDE + WL_CM))[i & 32767] = (bf16)(pk2(v, 0.f) & 0xffffu);
    }
    for (int i = gt; i < NL * 256; i += NGT) { const float lam = a.in[25][i]; const float sp = (lam > 15.f) ? expf(-lam) : log1pf(expf(-lam)); ((float*)(a.ws + WS_TAB))[i] = -8.0f * sp; }
}

__device__ __forceinline__ void tail_convert(const Args& a, int l, int slot, LAS unsigned char* lds) {
    if (l >= NL) return;
    int tid = threadIdx.x; asm volatile("" : "+v"(tid)); const int lane = tid & 63, wave = __builtin_amdgcn_readfirstlane(tid >> 6);
    LAS float* scr = (LAS float*)(lds + wave * 8448);
    for (int it = slot * NWAVE + wave; it < IT_LAYER; it += 320 * NWAVE) p0_weight_item(a, l, it, scr, lane);
    __syncthreads();
}
constexpr int OFF_BUS = 0, BUS_WAVE = 8448, OFF_SST = 67584, SST_WAVE = 4352, OFF_YS = 102400, OFF_RED2 = 136192;
template <bool FULL> __device__ __forceinline__ void s5_group(const Args& a, int l, int tile, int g, LAS unsigned char* lds, int lane, int wave) {
    const bf16* Z = (const bf16*)(a.ws + WS_HZ);
    const int t0 = tile * 64, fr = lane & 15, fq = lane >> 4;
    unsigned char* wl = a.ws + WS_W + (size_t)l * WL_STRIDE;
    const float* tab = (const float*)(wl + WL_S5T) + (size_t)g * 36 * 64; const bf16* BB = (const bf16*)(wl + WL_BB); const bf16* CM = (const bf16*)(wl + WL_CM);
    float* E = (float*)(a.ws + WS_S5E);
    LAS unsigned char* bus = lds + OFF_BUS + wave * BUS_WAVE; LAS unsigned char* sst = lds + OFF_SST + wave * SST_WAVE;
    const float lbr = tab[lane], lbi = tab[64 + lane];
    const bf16x8 zero8 = {0, 0, 0, 0, 0, 0, 0, 0};
    bf16x8 bbf[8];
#pragma unroll
    for (int kt = 0; kt < 8; ++kt) { bbf[kt] = zero8; if (fq < 2) bbf[kt] = *(const bf16x8*)(BB + (size_t)(g * 128 + kt * 16 + fr) * 16 + 8 * fq); }
    float sre = 0.f, sim = 0.f;
    bf16x8 cm[4]; f32x4 dsk;
    if (FULL) {
        sre = E[((size_t)(tile * 16 + g) * 2 + 0) * 64 + lane]; sim = E[((size_t)(tile * 16 + g) * 2 + 1) * 64 + lane];
#pragma unroll
        for (int ks = 0; ks < 4; ++ks) cm[ks] = *(const bf16x8*)(CM + (size_t)(g * 16 + fr) * 128 + 32 * ks + 8 * fq);
        dsk = *(const f32x4*)(a.in[14] + (size_t)l * 256 + g * 16 + 4 * fq);
    }
    bf16x8 ufa[4]; u32x2 urawa[4];
#pragma unroll
    for (int tb = 0; tb < 4; ++tb) { const bf16* zr = Z + (size_t)(t0 + tb * 16 + fr) * IW + g * 16;
        ufa[tb] = zero8; if (fq < 2) ufa[tb] = *(const bf16x8*)(zr + 8 * fq);
        if (FULL) urawa[tb] = *(const u32x2*)(zr + 4 * fq); }
#pragma unroll
    for (int tb = 0; tb < 4; ++tb) {
        const bf16x8 uf = ufa[tb]; u32x2 uraw; if (FULL) uraw = urawa[tb];
#pragma unroll
        for (int kt = 0; kt < 8; ++kt) { f32x4 d = {0.f, 0.f, 0.f, 0.f}; MFMA16(bbf[kt], uf, d); *(LAS f32x4*)(bus + (fr * 132 + kt * 16 + 4 * fq) * 4) = d; }
        lds_wait();
        float bra[16], bia[16];
#pragma unroll
        for (int tt = 0; tt < 16; ++tt) { bra[tt] = *(const LAS float*)(bus + (tt * 132 + lane) * 4); bia[tt] = *(const LAS float*)(bus + (tt * 132 + 64 + lane) * 4); }
#pragma unroll
        for (int tt = 0; tt < 16; ++tt) {
            const float br = bra[tt], bi = bia[tt];
            const float nre = lbr * sre - lbi * sim + br, nim = lbr * sim + lbi * sre + bi; sre = nre; sim = nim;
            if (FULL) { const unsigned pr = pk2(sre, sim);
                *(LAS bf16*)(sst + (tt * 136 + lane) * 2) = (bf16)(pr & 0xffffu); *(LAS bf16*)(sst + (tt * 136 + 64 + lane) * 2) = (bf16)(pr >> 16); }
        }
        if (FULL) {
            lds_wait();
            f32x4 acc = {0.f, 0.f, 0.f, 0.f};
#pragma unroll
            for (int ks = 0; ks < 4; ++ks) { const bf16x8 yv = *(const LAS bf16x8*)(sst + (fr * 136 + 32 * ks + 8 * fq) * 2); MFMA16(cm[ks], yv, acc); }
            const int t = tb * 16 + fr;
            f32x4 u4; u4.x = __uint_as_float(uraw.x << 16); u4.y = __uint_as_float(uraw.x & 0xffff0000u); u4.z = __uint_as_float(uraw.y << 16); u4.w = __uint_as_float(uraw.y & 0xffff0000u);
            const f32x4 v = acc + dsk * u4;
            u32x2 w; w.x = pk2(geluf_(v.x), geluf_(v.y)); w.y = pk2(geluf_(v.z), geluf_(v.w));
            *(LAS u32x2*)(lds + OFF_YS + (t * 264 + g * 16 + 4 * fq) * 2) = w;
        }
        lds_wait();
    }
    if (!FULL) { E[((size_t)(tile * 16 + g) * 2 + 0) * 64 + lane] = sre; E[((size_t)(tile * 16 + g) * 2 + 1) * 64 + lane] = sim; }
}
__device__ __forceinline__ void s5_m1(const Args& a, int l, int tile, LAS unsigned char* lds, int tid, int lane, int wave) {
    for (int gi = 0; gi < 2; ++gi) s5_group<false>(a, l, tile, wave * 2 + gi, lds, lane, wave);
    __syncthreads();
}
__device__ __forceinline__ void s5_m3(const Args& a, int l, int tile, LAS unsigned char* lds, int tid, int lane, int wave) {
    bf16* Y = (bf16*)(a.ws + WS_Y);
    const int t0 = tile * 64, fr = lane & 15, fq = lane >> 4;
    unsigned char* wl = a.ws + WS_W + (size_t)l * WL_STRIDE;
    for (int gi = 0; gi < 2; ++gi) s5_group<true>(a, l, tile, wave * 2 + gi, lds, lane, wave);
    __syncthreads();
    {
        const int cb = wave & 3, jh = wave >> 2; const bf16* WG = (const bf16*)(wl + WL_GLU);
        f32x4 acc[8];
#pragma unroll
        for (int jt = 0; jt < 8; ++jt) acc[jt] = (f32x4){0.f, 0.f, 0.f, 0.f};
#pragma unroll
        for (int ks = 0; ks < 8; ++ks) {
            const bf16x8 yv = *(const LAS bf16x8*)(lds + OFF_YS + ((cb * 16 + fr) * 264 + 32 * ks + 8 * fq) * 2);
#pragma unroll
            for (int jt = 0; jt < 8; ++jt) { const bf16x8 wv = *(const bf16x8*)(WG + (size_t)(jh * 128 + jt * 16 + fr) * 256 + 32 * ks + 8 * fq); MFMA16(wv, yv, acc[jt]); }
        }
        const int t = cb * 16 + fr; float ss = 0.f;
#pragma unroll
        for (int jt = 0; jt < 8; ++jt) {
            const int j0 = jh * 128 + jt * 16 + 4 * fq;
            const f32x4 bg = *(const f32x4*)(a.in[16] + (size_t)l * 256 + j0);
            const u32x2 yr = *(const LAS u32x2*)(lds + OFF_YS + (t * 264 + j0) * 2);
            f32x4 o;
            o.x = __uint_as_float(yr.x << 16) * sigmoidf_(acc[jt].x + bg.x); o.y = __uint_as_float(yr.x & 0xffff0000u) * sigmoidf_(acc[jt].y + bg.y);
            o.z = __uint_as_float(yr.y << 16) * sigmoidf_(acc[jt].z + bg.z); o.w = __uint_as_float(yr.y & 0xffff0000u) * sigmoidf_(acc[jt].w + bg.w);
            acc[jt] = o; ss += (o.x * o.x + o.y * o.y) + (o.z * o.z + o.w * o.w);
        }
        ss += __shfl_xor(ss, 16); ss += __shfl_xor(ss, 32);
        LAS float* red = (LAS float*)(lds + OFF_RED2);
        if (fq == 0) red[t * 2 + jh] = ss;
        __syncthreads();
        const float rstd = rsqrtf((red[t * 2] + red[t * 2 + 1]) * (1.0f / 256.0f) + EPS);
#pragma unroll
        for (int jt = 0; jt < 8; ++jt) { const int j0 = jh * 128 + jt * 16 + 4 * fq; u32x2 w; w.x = pk2(acc[jt].x * rstd, acc[jt].y * rstd); w.y = pk2(acc[jt].z * rstd, acc[jt].w * rstd);
            *(u32x2*)(Y + (size_t)(t0 + t) * DM + j0) = w; }
    }
    __syncthreads();
}

constexpr int OFF_LA = 0, OFF_LB = 65536, OFF_XC = 65536;
template <bool FULL> __device__ __forceinline__ void lru_tile(const Args& a, int l, int tile, LAS unsigned char* lds, int tid, int lane, int wave) {
    const bf16* Z = (const bf16*)(a.ws + WS_HZ); bf16* Y = (bf16*)(a.ws + WS_Y);
    const int t0 = tile * 64, fr = lane & 15, fq = lane >> 4; const int tloc0 = (tile & 127) * 64;
    unsigned char* wl = a.ws + WS_W + (size_t)l * WL_STRIDE;
    if constexpr (FULL) {
#pragma unroll
        for (int it = 0; it < 4; ++it) { const int ch = it * NTHR + tid, t = ch >> 5, c8 = ch & 31;
            const u32x4 lv = *(const u32x4*)(Y + (size_t)(t0 + t) * DM + 768 + c8 * 8), bw = *(const u32x4*)(Y + (size_t)(t0 + t) * DM + 512 + c8 * 8);
            float lf[8], bf[8]; unpack8(lv, lf); unpack8(bw, bf);
            LAS f32x4* pa = (LAS f32x4*)(lds + OFF_LA + (t * 256 + c8 * 8) * 4); LAS f32x4* pb = (LAS f32x4*)(lds + OFF_LB + (t * 256 + c8 * 8) * 4);
            pa[0] = (f32x4){__expf(lf[0]), __expf(lf[1]), __expf(lf[2]), __expf(lf[3])}; pa[1] = (f32x4){__expf(lf[4]), __expf(lf[5]), __expf(lf[6]), __expf(lf[7])};
            pb[0] = (f32x4){bf[0], bf[1], bf[2], bf[3]}; pb[1] = (f32x4){bf[4], bf[5], bf[6], bf[7]}; }
    } else {
#pragma unroll
    for (int it = 0; it < 4; ++it) {
        const int ch = it * NTHR + tid, t = ch >> 5, c8 = ch & 31;
        float xc[8];
        { const f32x4 b0 = *(const f32x4*)(a.in[20] + (size_t)l * 256 + c8 * 8), b1 = *(const f32x4*)(a.in[20] + (size_t)l * 256 + c8 * 8 + 4);
          xc[0] = b0.x; xc[1] = b0.y; xc[2] = b0.z; xc[3] = b0.w; xc[4] = b1.x; xc[5] = b1.y; xc[6] = b1.z; xc[7] = b1.w; }
#pragma unroll
        for (int j = 0; j < 4; ++j) {
            if (tloc0 + t + j - 3 >= 0) {
                const u32x4 v = *(const u32x4*)(Z + (size_t)(t0 + t + j - 3) * IW + 2304 + c8 * 8); float f[8]; unpack8(v, f);
                const f32x4 w0 = *(const f32x4*)(a.in[19] + ((size_t)l * 4 + j) * 256 + c8 * 8), w1 = *(const f32x4*)(a.in[19] + ((size_t)l * 4 + j) * 256 + c8 * 8 + 4);
                xc[0] = fmaf(w0.x, f[0], xc[0]); xc[1] = fmaf(w0.y, f[1], xc[1]); xc[2] = fmaf(w0.z, f[2], xc[2]); xc[3] = fmaf(w0.w, f[3], xc[3]);
                xc[4] = fmaf(w1.x, f[4], xc[4]); xc[5] = fmaf(w1.y, f[5], xc[5]); xc[6] = fmaf(w1.z, f[6], xc[6]); xc[7] = fmaf(w1.w, f[7], xc[7]);
            }
        }
        u32x4 w; w.x = pk2(xc[0], xc[1]); w.y = pk2(xc[2], xc[3]); w.z = pk2(xc[4], xc[5]); w.w = pk2(xc[6], xc[7]);
        *(LAS u32x4*)(lds + OFF_XC + (t * 264 + c8 * 8) * 2) = w;
    }
    __syncthreads();
    {
        const int cb = wave & 3, chh = wave >> 2; const bf16* WA = (const bf16*)(wl + WL_WA); const bf16* WX = (const bf16*)(wl + WL_WX);
        const float* c8t = (const float*)(a.ws + WS_TAB) + (size_t)l * 256;
        f32x4 av[8], bv[8];
#pragma unroll
        for (int et = 0; et < 8; ++et) {
            const int e0 = chh * 128 + et * 16, nb = e0 >> 6, el = e0 & 63;
            f32x4 ra = {0.f, 0.f, 0.f, 0.f}, ia = {0.f, 0.f, 0.f, 0.f};
#pragma unroll
            for (int ks = 0; ks < 2; ++ks) {
                const bf16x8 xv = *(const LAS bf16x8*)(lds + OFF_XC + ((cb * 16 + fr) * 264 + nb * 64 + 32 * ks + 8 * fq) * 2);
                const bf16x8 wa = *(const bf16x8*)(WA + (size_t)nb * 4096 + (el + fr) * 64 + 32 * ks + 8 * fq);
                const bf16x8 wx = *(const bf16x8*)(WX + (size_t)nb * 4096 + (el + fr) * 64 + 32 * ks + 8 * fq);
                MFMA16(wa, xv, ra); MFMA16(wx, xv, ia);
            }
            const int c0 = e0 + 4 * fq;
            const f32x4 ba = *(const f32x4*)(a.in[22] + (size_t)l * 256 + c0), bx = *(const f32x4*)(a.in[24] + (size_t)l * 256 + c0), c8v = *(const f32x4*)(c8t + c0);
            const u32x2 xr = *(const LAS u32x2*)(lds + OFF_XC + ((cb * 16 + fr) * 264 + c0) * 2);
            float lav[4];
            const float xcv[4] = {__uint_as_float(xr.x << 16), __uint_as_float(xr.x & 0xffff0000u), __uint_as_float(xr.y << 16), __uint_as_float(xr.y & 0xffff0000u)};
#pragma unroll
            for (int r = 0; r < 4; ++r) {
                const float rg = sigmoidf_(ra[r] + ba[r]), ig = sigmoidf_(ia[r] + bx[r]);
                const float la = c8v[r] * rg; const float av_ = __expf(la); const float m2 = -expm1f(2.0f * la);
                av[et][r] = av_; bv[et][r] = sqrtf(fmaxf(m2, 0.f)) * ig * xcv[r]; lav[r] = la;
            }
            {
              bf16* yr = Y + (size_t)(t0 + cb * 16 + fr) * DM + c0;
              u32x2 wl_; wl_.x = pk2(lav[0], lav[1]); wl_.y = pk2(lav[2], lav[3]); *(u32x2*)(yr + 768) = wl_;
              u32x2 wb_; wb_.x = pk2(bv[et][0], bv[et][1]); wb_.y = pk2(bv[et][2], bv[et][3]); *(u32x2*)(yr + 512) = wb_; }
            if ((et & 3) == 3) asm volatile("" ::: "memory");
        }
        __syncthreads();
#pragma unroll
        for (int et = 0; et < 8; ++et) { const int c0 = chh * 128 + et * 16 + 4 * fq, t = cb * 16 + fr;
            *(LAS f32x4*)(lds + OFF_LA + (t * 256 + c0) * 4) = av[et]; *(LAS f32x4*)(lds + OFF_LB + (t * 256 + c0) * 4) = bv[et]; }
    }
    }
    __syncthreads();
    float* AE = (float*)(a.ws + WS_LRUC); float* HE = AE + 2 * 128 * 256;
    if (tid < 256) {
        LAS float* A = (LAS float*)(lds + OFF_LA) + tid; LAS float* B = (LAS float*)(lds + OFF_LB) + tid;
        float h = FULL ? HE[(size_t)tile * 256 + tid] : 0.f, P = 1.f;
        for (int tb = 0; tb < 64; tb += 16) {
            float av_[16], bv_[16];
#pragma unroll
            for (int j = 0; j < 16; ++j) { av_[j] = A[(tb + j) * 256]; bv_[j] = B[(tb + j) * 256]; }
#pragma unroll
            for (int j = 0; j < 16; ++j) { h = fmaf(av_[j], h, bv_[j]); if (FULL) bv_[j] = h; else P *= av_[j]; }
            if (FULL) {
#pragma unroll
                for (int j = 0; j < 16; ++j) B[(tb + j) * 256] = bv_[j];
            }
        }
        if (!FULL) { AE[(size_t)tile * 256 + tid] = P; HE[(size_t)tile * 256 + tid] = h; }
    }
    __syncthreads();
    if (FULL) {
#pragma unroll
        for (int it = 0; it < 4; ++it) {
            const int ch = it * NTHR + tid, t = ch >> 5, c8 = ch & 31;
            const LAS f32x4* hp = (const LAS f32x4*)(lds + OFF_LB + (t * 256 + c8 * 8) * 4); const f32x4 h0 = hp[0], h1 = hp[1];
            const u32x4 gv = *(const u32x4*)(Z + (size_t)(t0 + t) * IW + 2560 + c8 * 8); float g[8]; unpack8(gv, g);
            float o[8] = {h0.x * g[0], h0.y * g[1], h0.z * g[2], h0.w * g[3], h1.x * g[4], h1.y * g[5], h1.z * g[6], h1.w * g[7]};
            float ss = 0.f;
#pragma unroll
            for (int i = 0; i < 8; ++i) ss += o[i] * o[i];
#pragma unroll
            for (int s = 1; s < 32; s <<= 1) ss += __shfl_xor(ss, s);
            const float rstd = rsqrtf(ss * (1.0f / 256.0f) + EPS);
            u32x4 w; w.x = pk2(o[0] * rstd, o[1] * rstd); w.y = pk2(o[2] * rstd, o[3] * rstd); w.z = pk2(o[4] * rstd, o[5] * rstd); w.w = pk2(o[6] * rstd, o[7] * rstd);
            *(u32x4*)(Y + (size_t)(t0 + t) * DM + 768 + c8 * 8) = w;
        }
        __syncthreads();
    }
}

constexpr int OFF_QS = 0, OFF_KS = 17408, OFF_VT = 52224, OFF_PT = 87040, OFF_SS = 121856, OFF_RED = 139264;
__device__ __forceinline__ float ret_lg2(int h) { return log2f(1.0f - exp2f(-5.0f - (float)h)); }
typedef short s16x4 __attribute__((ext_vector_type(4)));
__device__ __forceinline__ bf16x8 tr_frag(LAS unsigned char* base, int stride, int k0, int c0, int lane) {
    const int fq = lane >> 4, q = (lane & 15) >> 2, p = lane & 3;
    LAS unsigned char* a0 = base + (k0 + 8 * fq + q) * stride + (c0 + 4 * p) * 2;
    const s16x4 lo = __builtin_amdgcn_ds_read_tr16_b64_v4i16((LAS s16x4*)a0);
    const s16x4 hi = __builtin_amdgcn_ds_read_tr16_b64_v4i16((LAS s16x4*)(a0 + 4 * stride));
    return (bf16x8){lo[0], lo[1], lo[2], lo[3], hi[0], hi[1], hi[2], hi[3]};
}
template <int NR, bool ZETA> __device__ __forceinline__ void ret_load_R(const bf16* Z, int r0, int c0, LAS unsigned char* dst, int tid, float lg2) {
#pragma unroll
    for (int it = 0; it < NR / 32; ++it) { const int ch = it * NTHR + tid, r = ch >> 4, c = ch & 15;
        u32x4 v = *(const u32x4*)(Z + (size_t)(r0 + r) * IW + c0 + c * 8);
        if (ZETA) { const float zs = exp2f((float)(127 - r) * lg2); float f[8]; unpack8(v, f);
            v.x = pk2(f[0] * zs, f[1] * zs); v.y = pk2(f[2] * zs, f[3] * zs); v.z = pk2(f[4] * zs, f[5] * zs); v.w = pk2(f[6] * zs, f[7] * zs); }
        *(LAS u32x4*)(dst + (r * 136 + c * 8) * 2) = v; }
}
template <bool ZETA> __device__ __forceinline__ void ret_load_T(const bf16* Z, int r0, int c0, LAS unsigned char* dst, int tid, float lg2) {
    const int m = tid & 127; const float zs = ZETA ? exp2f((float)(127 - m) * lg2) : 1.0f;
#pragma unroll
    for (int it = 0; it < 4; ++it) { const int dc = (tid >> 7) + 4 * it;
        const u32x4 v = *(const u32x4*)(Z + (size_t)(r0 + m) * IW + c0 + dc * 8); float f[8]; unpack8(v, f);
#pragma unroll
        for (int i = 0; i < 8; i += 2) { const unsigned pr = pk2(f[i] * zs, f[i + 1] * zs);
            *(LAS bf16*)(dst + ((dc * 8 + i) * 136 + m) * 2) = (bf16)(pr & 0xffffu); *(LAS bf16*)(dst + ((dc * 8 + i + 1) * 136 + m) * 2) = (bf16)(pr >> 16); }
    }
}
__device__ __forceinline__ void ret_kv(const Args& a, int unit, LAS unsigned char* lds, int tid, int lane, int wave) {
    const bf16* Z = (const bf16*)(a.ws + WS_HZ);
    const int n = unit & 63, bh = unit >> 6, h = bh & 3, b = bh >> 2, r0 = b * SEQ + n * 128, fr = lane & 15, fq = lane >> 4;
    const float lg2 = ret_lg2(h);
    ret_load_R<128, true>(Z, r0, 768 + h * 128, lds + OFF_KS, tid, lg2);
    ret_load_R<128, false>(Z, r0, 1280 + h * 128, lds + OFF_VT, tid, lg2);
    __syncthreads();
    const int eb = (wave & 3) * 32, dh = (wave >> 2) * 64;
    f32x4 acc[2][4];
#pragma unroll
    for (int i = 0; i < 2; ++i)
#pragma unroll
        for (int j = 0; j < 4; ++j) acc[i][j] = (f32x4){0.f, 0.f, 0.f, 0.f};
#pragma unroll
    for (int ks = 0; ks < 4; ++ks) {
        bf16x8 vf[2], kf[4];
#pragma unroll
        for (int i = 0; i < 2; ++i) vf[i] = tr_frag(lds + OFF_VT, 272, 32 * ks, eb + i * 16, lane);
#pragma unroll
        for (int j = 0; j < 4; ++j) kf[j] = tr_frag(lds + OFF_KS, 272, 32 * ks, dh + j * 16, lane);
#pragma unroll
        for (int i = 0; i < 2; ++i)
#pragma unroll
            for (int j = 0; j < 4; ++j) MFMA16(kf[j], vf[i], acc[i][j]);
        asm volatile("" ::: "memory");
    }
    float* KV = (float*)(a.ws + WS_KV) + (size_t)unit * 16384;
#pragma unroll
    for (int i = 0; i < 2; ++i)
#pragma unroll
        for (int j = 0; j < 4; ++j) *(f32x4*)(KV + (size_t)(eb + i * 16 + fr) * 128 + dh + j * 16 + 4 * fq) = acc[i][j];
    __syncthreads();
}
__device__ __forceinline__ void ret_out(const Args& a, int tile, LAS unsigned char* lds, int tid, int lane, int wave) {
    const bf16* Z = (const bf16*)(a.ws + WS_HZ); bf16* Y = (bf16*)(a.ws + WS_Y); const bf16* PB = (const bf16*)(a.ws + WS_PB);
    const int b = tile >> 7, n = (tile & 127) >> 1, half = tile & 1, t0 = tile * 64, k0 = b * SEQ + n * 128, fr = lane & 15, fq = lane >> 4;
    const int cb = wave & 3, hv = wave >> 2;
    const int cg = half * 64 + cb * 16 + fr;
    const int nit = half ? 4 : 2;
    LAS float* red = (LAS float*)(lds + OFF_RED);
    const int lr = tid >> 4, lc = tid & 15;
    u32x4 rq[2], rk[4], rv[4], rp[4];
#define RET_ISSUE(h_) do { \
        _Pragma("unroll") for (int it = 0; it < 2; ++it) rq[it] = *(const u32x4*)(Z + (size_t)(t0 + it * 32 + lr) * IW + 256 + (h_) * 128 + lc * 8); \
        _Pragma("unroll") for (int it = 0; it < 4; ++it) if (it < nit) { rk[it] = *(const u32x4*)(Z + (size_t)(k0 + it * 32 + lr) * IW + 768 + (h_) * 128 + lc * 8); \
                                                                          rv[it] = *(const u32x4*)(Z + (size_t)(k0 + it * 32 + lr) * IW + 1280 + (h_) * 128 + lc * 8); } \
        { const bf16* P_ = PB + (size_t)(((b * 4 + (h_)) * 64) + n) * 16384; \
          _Pragma("unroll") for (int it = 0; it < 4; ++it) rp[it] = *(const u32x4*)(P_ + (size_t)(it * 32 + lr) * 128 + lc * 8); } } while (0)
    RET_ISSUE(0);
    float ss512 = 0.f;
#pragma unroll 1
    for (int h = 0; h < 4; ++h) {
        const float lg2 = ret_lg2(h);
#pragma unroll
        for (int it = 0; it < 2; ++it) *(LAS u32x4*)(lds + OFF_QS + ((it * 32 + lr) * 136 + lc * 8) * 2) = rq[it];
#pragma unroll
        for (int it = 0; it < 4; ++it) if (it < nit) { *(LAS u32x4*)(lds + OFF_KS + ((it * 32 + lr) * 136 + lc * 8) * 2) = rk[it]; *(LAS u32x4*)(lds + OFF_VT + ((it * 32 + lr) * 136 + lc * 8) * 2) = rv[it]; }
#pragma unroll
        for (int it = 0; it < 4; ++it) *(LAS u32x4*)(lds + OFF_PT + ((it * 32 + lr) * 136 + lc * 8) * 2) = rp[it];
        __syncthreads();
        if (h < 3) RET_ISSUE(h + 1);
        u32x2 gr[4];
#pragma unroll
        for (int et = 0; et < 4; ++et) gr[et] = *(const u32x2*)(Z + (size_t)(t0 + cb * 16 + fr) * IW + 1792 + h * 128 + hv * 64 + et * 16 + 4 * fq);
        if (hv == 0 || half) {
            f32x4 sc[4];
#pragma unroll
            for (int mt = 0; mt < 4; ++mt) sc[mt] = (f32x4){0.f, 0.f, 0.f, 0.f};
#pragma unroll
            for (int ks = 0; ks < 4; ++ks) {
                const bf16x8 qf = *(const LAS bf16x8*)(lds + OFF_QS + ((cb * 16 + fr) * 136 + 32 * ks + 8 * fq) * 2);
#pragma unroll
                for (int mt = 0; mt < 4; ++mt) { const bf16x8 kf = *(const LAS bf16x8*)(lds + OFF_KS + ((hv * 64 + mt * 16 + fr) * 136 + 32 * ks + 8 * fq) * 2); MFMA16(kf, qf, sc[mt]); }
            }
#pragma unroll
            for (int mt = 0; mt < 4; ++mt) { const int m0 = hv * 64 + mt * 16 + 4 * fq; float v[4];
#pragma unroll
                for (int r = 0; r < 4; ++r) { const int dm = cg - (m0 + r); v[r] = (dm >= 0) ? sc[mt][r] * exp2f((float)dm * lg2) : 0.f; }
                u32x2 w; w.x = pk2(v[0], v[1]); w.y = pk2(v[2], v[3]);
                *(LAS u32x2*)(lds + OFF_SS + ((cb * 16 + fr) * 136 + m0) * 2) = w; }
        }
        __syncthreads();
        f32x4 oi[4], oc[4];
#pragma unroll
        for (int et = 0; et < 4; ++et) { oi[et] = (f32x4){0.f, 0.f, 0.f, 0.f}; oc[et] = (f32x4){0.f, 0.f, 0.f, 0.f}; }
#pragma unroll
        for (int ks = 0; ks < 4; ++ks) {
            const bf16x8 qf = *(const LAS bf16x8*)(lds + OFF_QS + ((cb * 16 + fr) * 136 + 32 * ks + 8 * fq) * 2);
#pragma unroll
            for (int et = 0; et < 4; ++et) { const bf16x8 pf = *(const LAS bf16x8*)(lds + OFF_PT + ((hv * 64 + et * 16 + fr) * 136 + 32 * ks + 8 * fq) * 2); MFMA16(pf, qf, oc[et]); }
            if (ks < nit) {
                const bf16x8 sf = *(const LAS bf16x8*)(lds + OFF_SS + ((cb * 16 + fr) * 136 + 32 * ks + 8 * fq) * 2);
#pragma unroll
                for (int et = 0; et < 4; ++et) { const bf16x8 vf = tr_frag(lds + OFF_VT, 272, 32 * ks, hv * 64 + et * 16, lane); MFMA16(vf, sf, oi[et]); }
            }
        }
        const float xi = exp2f((float)(cg + 1) * lg2);
        float ss = 0.f;
#pragma unroll
        for (int et = 0; et < 4; ++et) { oi[et] = oi[et] + oc[et] * xi; ss += (oi[et].x * oi[et].x + oi[et].y * oi[et].y) + (oi[et].z * oi[et].z + oi[et].w * oi[et].w); }
        ss += __shfl_xor(ss, 16); ss += __shfl_xor(ss, 32);
        if (fq == 0) red[(h * 64 + cb * 16 + fr) * 2 + hv] = ss;
        __syncthreads();
        const float rstd = rsqrtf((red[(h * 64 + cb * 16 + fr) * 2] + red[(h * 64 + cb * 16 + fr) * 2 + 1]) * (1.0f / 128.0f) + EPS);
#pragma unroll
        for (int et = 0; et < 4; ++et) {
            f32x4 o;
            o.x = oi[et].x * rstd * __uint_as_float(gr[et].x << 16); o.y = oi[et].y * rstd * __uint_as_float(gr[et].x & 0xffff0000u);
            o.z = oi[et].z * rstd * __uint_as_float(gr[et].y << 16); o.w = oi[et].w * rstd * __uint_as_float(gr[et].y & 0xffff0000u);
            ss512 += (o.x * o.x + o.y * o.y) + (o.z * o.z + o.w * o.w);
            u32x2 w; w.x = pk2(o.x, o.y); w.y = pk2(o.z, o.w);
            *(u32x2*)(Y + (size_t)(t0 + cb * 16 + fr) * DM + 256 + h * 128 + hv * 64 + et * 16 + 4 * fq) = w;
        }
    }
#undef RET_ISSUE
    ss512 += __shfl_xor(ss512, 16); ss512 += __shfl_xor(ss512, 32);
    LAS float* red5 = red + 512;
    if (fq == 0) red5[(cb * 16 + fr) * 2 + hv] = ss512;
    __syncthreads();
    const float rstd = rsqrtf((red5[(cb * 16 + fr) * 2] + red5[(cb * 16 + fr) * 2 + 1]) * (1.0f / 512.0f) + EPS);
#pragma unroll 1
    for (int h = 0; h < 4; ++h)
#pragma unroll
        for (int et = 0; et < 4; ++et) { u32x2* yp = (u32x2*)(Y + (size_t)(t0 + cb * 16 + fr) * DM + 256 + h * 128 + hv * 64 + et * 16 + 4 * fq); const u32x2 r = *yp;
            u32x2 w; w.x = pk2(__uint_as_float(r.x << 16) * rstd, __uint_as_float(r.x & 0xffff0000u) * rstd); w.y = pk2(__uint_as_float(r.y << 16) * rstd, __uint_as_float(r.y & 0xffff0000u) * rstd);
            *yp = w; }
    __syncthreads();
}

__device__ __forceinline__ void m2_scans(const Args& a, int l, int tid, int G) {
    const int gt = blockIdx.x * NTHR + tid, NGT = G * NTHR;
    for (int i = gt; i < 8 * 16384; i += NGT) {
        const int bh = i >> 14, ed = i & 16383, h = bh & 3;
        const float gC = exp2f(128.0f * ret_lg2(h));
        const float* p = (const float*)(a.ws + WS_KV) + (size_t)bh * 64 * 16384 + ed; bf16* pb = (bf16*)(a.ws + WS_PB) + (size_t)bh * 64 * 16384 + ed;
        float S = 0.f;
        {
            float v[64];
#pragma unroll
            for (int j = 0; j < 64; ++j) v[j] = p[(size_t)j * 16384];
#pragma unroll
            for (int j = 0; j < 64; ++j) { pb[(size_t)j * 16384] = (bf16)(pk2(S, 0.f) & 0xffffu); S = fmaf(gC, S, v[j]); }
        }
    }
    const int rt = NGT - 1 - gt;
    if (rt < 2048) {
        const int p = rt & 63, g = (rt >> 6) & 15, b = rt >> 10;
        const float* tab = (const float*)(a.ws + WS_W + (size_t)l * WL_STRIDE + WL_S5T) + (size_t)g * 36 * 64;
        const float cr = tab[128 + p], ci = tab[192 + p];
        float* E = (float*)(a.ws + WS_S5E);
        float sre = 0.f, sim = 0.f;
        for (int nb = 0; nb < 128; nb += 32) {
            float er[32], ei[32];
#pragma unroll
            for (int j = 0; j < 32; ++j) { const size_t o = ((size_t)((b * 128 + nb + j) * 16 + g) * 2) * 64 + p; er[j] = E[o]; ei[j] = E[o + 64]; }
#pragma unroll
            for (int j = 0; j < 32; ++j) { const size_t o = ((size_t)((b * 128 + nb + j) * 16 + g) * 2) * 64 + p; E[o] = sre; E[o + 64] = sim;
                const float nre = cr * sre - ci * sim + er[j], nim = cr * sim + ci * sre + ei[j]; sre = nre; sim = nim; }
        }
    } else if (rt < 2048 + 512) {
        const int q = rt - 2048, ch = q & 255, b = q >> 8;
        float* AE = (float*)(a.ws + WS_LRUC); float* HE = AE + 2 * 128 * 256;
        float hcar = 0.f;
        for (int nb = 0; nb < 128; nb += 32) {
            float av[32], hv[32];
#pragma unroll
            for (int j = 0; j < 32; ++j) { const size_t o = (size_t)(b * 128 + nb + j) * 256 + ch; av[j] = AE[o]; hv[j] = HE[o]; }
#pragma unroll
            for (int j = 0; j < 32; ++j) { const size_t o = (size_t)(b * 128 + nb + j) * 256 + ch; HE[o] = hcar; hcar = fmaf(av[j], hcar, hv[j]); }
        }
    }
}

__global__ void __launch_bounds__(NTHR, 2) fwd_kernel(Args a) {
    extern __shared__ __attribute__((aligned(16))) unsigned char lds_raw[];
    LAS unsigned char* lds = (LAS unsigned char*)lds_raw;
    cg::grid_group grid = cg::this_grid();
    const int G = gridDim.x;
#define PH_IDS int tid = threadIdx.x; asm volatile("" : "+v"(tid)); const int lane = tid & 63, wave = __builtin_amdgcn_readfirstlane(tid >> 6); (void)lane; (void)wave;
    bf16* XB = (bf16*)(a.ws + WS_XB); bf16* HZ = (bf16*)(a.ws + WS_HZ); bf16* Y = (bf16*)(a.ws + WS_Y); float* SSQ = (float*)(a.ws + WS_SSQ);
    const float* RC = (const float*)(a.ws + WS_ROPE); const float* RS = RC + SEQ * 64;

    volatile LAS unsigned* MISC = (volatile LAS unsigned*)(lds + MISC_OFF);
    if (threadIdx.x < 16) MISC[threadIdx.x] = 0u;
    __syncthreads();
    const XcdBarrier bar = xcd_barrier_post((unsigned*)(a.ws + WS_CTL) + CW_BAR, MISC + 8);
    { PH_IDS p0_prologue(a, lds, tid, lane, wave, G); }
    grid.sync();
#define GRID_BAR() xcd_barrier(bar)

    for (int l = 0; l < NL; ++l) {
        unsigned char* wl = a.ws + WS_W + (size_t)l * WL_STRIDE;
#pragma unroll 1
        for (int f = 0; f < 2; ++f) {
            if (f == 1) {
                { pg8::Gemm g{XB, (const bf16*)(wl + WL_WIN), NTOK, IW, DM}; pg8::StaticOrder S; S.init(NTOK, IW, G, (int)blockIdx.x);
                  EpiWin E{HZ, SSQ, RC, RS, lds + OFF_SSQL};
                  pg8::gemm_phase<EpiWin, pg8::StaticOrder, true, true>(lds, g, S, E); }
                if (G == 256 && blockIdx.x >= 192) tail_convert(a, l + 1, 128 + (int)blockIdx.x - 192, lds);
                GRID_BAR();
                for (int it = blockIdx.x; it < 768; it += G) { PH_IDS
                    const int bx = it & 255, s = it >> 8, xq = bx & 7, jq = bx >> 3;
                    if (it < 256) { const int tile = (G == 256) ? xq * 32 + jq : it; s5_m1(a, l, tile, lds, tid, lane, wave); lru_tile<false>(a, l, tile, lds, tid, lane, wave); }
                    else { const int q = jq + 32 * (s - 1); const int unit = (G == 256) ? (((xq >> 2) * 4 + (q & 3)) * 64 + (xq & 3) * 16 + (q >> 2)) : it - 256; ret_kv(a, unit, lds, tid, lane, wave); }
                }
                GRID_BAR();
                { PH_IDS m2_scans(a, l, tid, G); }
                GRID_BAR();
                for (int it0 = blockIdx.x; it0 < 256; it0 += G) {
                    const int it = (G == 256) ? (it0 & 7) * 32 + (it0 >> 3) : it0;
                    { PH_IDS lru_tile<true>(a, l, it, lds, tid, lane, wave); }
                    { PH_IDS ret_out(a, it, lds, tid, lane, wave); }
                    { PH_IDS s5_m3(a, l, it, lds, tid, lane, wave); }
                }
                GRID_BAR();
                { pg8::Gemm g{Y, (const bf16*)(wl + WL_WOUT), NTOK, DM, DM}; pg8::StaticOrder S; S.init(NTOK, DM, G, (int)blockIdx.x);
                  EpiRes E{XB, SSQ, 1.0f, 1.0f};
                  pg8::gemm_phase<EpiRes, pg8::StaticOrder, true, true>(lds, g, S, E); }
                GRID_BAR();
            }
            { pg8::Gemm g{XB, (const bf16*)(wl + (f ? WL_GU2 : WL_GU1)), NTOK, 2 * FF, DM}; pg8::StaticOrder S; S.init(NTOK, 2 * FF, G, (int)blockIdx.x);
              EpiGU E{HZ, SSQ, lds + OFF_SSQL};
              pg8::gemm_phase<EpiGU, pg8::StaticOrder, true, true>(lds, g, S, E); }
            if (G == 256 && blockIdx.x >= 128) tail_convert(a, l + 1, f * 192 + (int)blockIdx.x - 128, lds);
            GRID_BAR();
            { pg8::Gemm g{HZ, (const bf16*)(wl + (f ? WL_D2 : WL_D1)), NTOK, DM, FF}; pg8::StaticOrder S; S.init(NTOK, DM, G, (int)blockIdx.x);
              EpiRes E{XB, SSQ, 0.5f, 2.0f};
              pg8::gemm_phase<EpiRes, pg8::StaticOrder, true, true>(lds, g, S, E); }
            GRID_BAR();
        }
    }
    { PH_IDS
        const int gw = blockIdx.x * NWAVE + wave, NGW = G * NWAVE; const float* fn = a.in[32];
        for (int m = gw; m < NTOK; m += NGW) {
            const u32x2* xr = (const u32x2*)(XB + (size_t)m * DM) + lane; f32x4* orow = (f32x4*)(a.out + (size_t)m * DM) + lane; f32x4 v[4]; float s = 0.f;
#pragma unroll
            for (int j = 0; j < 4; ++j) { const u32x2 r = xr[64 * j]; v[j] = (f32x4){__uint_as_float(r.x << 16), __uint_as_float(r.x & 0xffff0000u), __uint_as_float(r.y << 16), __uint_as_float(r.y & 0xffff0000u)};
                s += (v[j].x * v[j].x + v[j].y * v[j].y) + (v[j].z * v[j].z + v[j].w * v[j].w); }
            const float rstd = rsqrtf(wave_sum(s) * (1.0f / DM) + EPS);
#pragma unroll
            for (int j = 0; j < 4; ++j) { const f32x4 gn = *((const f32x4*)fn + lane + 64 * j); orow[64 * j] = v[j] * rstd * gn; }
        }
    }
}

extern "C" void kernel_launch(void* const* d_in, const int* in_sizes, int n_in, void* d_out, int out_size, void* d_ws, size_t ws_size, hipStream_t stream) {
    static int grid = 0;
    if (grid == 0) {
        if (n_in != 33 || in_sizes[0] != NTOK * DM || out_size != NTOK * DM || ws_size < WS_END) { fprintf(stderr, "kernel_launch: unexpected shapes (n_in %d, in0 %d, out %d, ws %zu < %zu)\n", n_in, n_in > 0 ? in_sizes[0] : -1, out_size, ws_size, (size_t)WS_END); grid = -1; return; }
        int dev = 0, cus = 0, per_cu = 0;
        hipGetDevice(&dev); hipDeviceGetAttribute(&cus, hipDeviceAttributeMultiprocessorCount, dev);
        if (hipFuncSetAttribute((const void*)fwd_kernel, hipFuncAttributeMaxDynamicSharedMemorySize, LDS_BYTES) != hipSuccess) { fprintf(stderr, "kernel_launch: hipFuncSetAttribute failed\n"); grid = -1; return; }
        if (hipOccupancyMaxActiveBlocksPerMultiprocessor(&per_cu, (const void*)fwd_kernel, NTHR, LDS_BYTES) != hipSuccess || per_cu < 1) { fprintf(stderr, "kernel_launch: occupancy query says %d\n", per_cu); per_cu = 1; }
        (void)hipGetLastError();
        grid = cus * 1;
    }
    if (grid < 0) return;
    Args a{};
    for (int i = 0; i < 33; ++i) a.in[i] = (const float*)d_in[i];
    a.out = (float*)d_out; a.ws = (unsigned char*)d_ws;
    if (hipMemsetAsync((char*)d_ws + WS_CTL, 0, 65536, stream) != hipSuccess) { fprintf(stderr, "kernel_launch: memset failed\n"); return; }
    void* args[] = {&a};
    hipError_t e = hipLaunchCooperativeKernel((const void*)fwd_kernel, dim3(grid), dim3(NTHR), args, LDS_BYTES, stream);
    if (e != hipSuccess) fprintf(stderr, "kernel_launch: cooperative launch failed: %s (grid %d)\n", hipGetErrorString(e), grid);
}
```

```cpp
#include <hip/hip_runtime.h>
#include <hip/hip_cooperative_groups.h>
#include <cstdio>
#include <cstdint>
namespace cg = cooperative_groups;
namespace pg8 {
#define PG8_LAS __attribute__((address_space(3)))
typedef unsigned short bf16_t;
typedef short bf16x8 __attribute__((ext_vector_type(8)));
typedef float f32x4 __attribute__((ext_vector_type(4)));
typedef unsigned u32x4 __attribute__((ext_vector_type(4)));
constexpr int BM = 256, BK = 64, HALF = 128, HTB = HALF * BK * 2  , STAGE_BYTES = 8 * HTB, NXCD = 8, WGM = 4;

__host__ __device__ __forceinline__ int lds_byte(int r, int c) { const int st = (r >> 4) * 2 + (c >> 5), rr = r & 15, cc = c & 31, ob = rr * 64 + cc * 2; return st * 1024 + (ob ^ (((ob >> 9) & 1) << 5)); }
__host__ __device__ __forceinline__ void stage_rc(int b, int& R, int& C) { const int st = b / 1024, sb = b % 1024, swz = sb ^ (((sb >> 9) & 1) << 5); R = (st >> 1) * 16 + swz / 64; C = (st & 1) * 32 + (swz % 64) / 2; }
__host__ __device__ __forceinline__ int perm32(int rho) { const int n = rho >> 4, i = rho & 15; return 8 * (i >> 2) + 4 * n + (i & 3); }

struct Unit { int pm, pn; };
struct Gemm { const bf16_t* A; const bf16_t* Bt; int M, N, K; };

struct StaticOrder {
    int nM, nN, nwg, G, c;
    __host__ __device__ void init(int M, int N, int G_, int c_) { nM = M / BM; nN = N / BM; nwg = nM * nN; G = G_; c = c_; }
    __host__ __device__ bool next(int i, Unit& u) const {
        const long L = (long)i * G + c; if (L >= nwg) return false;
        int wgid = (int)L; { const int q = nwg / NXCD, r = nwg % NXCD, xcd = wgid % NXCD, off = wgid / NXCD; wgid = (xcd < r ? xcd * (q + 1) : r * (q + 1) + (xcd - r) * q) + off; }
        const int nig = WGM * nN, gid = wgid / nig, fm = gid * WGM, gsz = (nM - fm) < WGM ? (nM - fm) : WGM;
        u.pm = fm + ((wgid % nig) % gsz); u.pn = (wgid % nig) / gsz; return true;
    }
    __device__ __forceinline__ void a_ready(const Unit&) const {}
    __device__ __forceinline__ void done(const Unit&) const {}
};

__device__ __forceinline__ unsigned cvt_pk_bf16(float lo, float hi) { unsigned r; asm volatile("v_cvt_pk_bf16_f32 %0, %1, %2" : "=v"(r) : "v"(lo), "v"(hi)); return r; }
template <class Epi, class Sched, bool ALIGN_EPI = false, bool SP2 = false>
__device__ __forceinline__ void gemm_phase(PG8_LAS unsigned char* lds, const Gemm g, const Sched& S, const Epi& E) {
    int tid_ = threadIdx.x; asm volatile("" : "+v"(tid_)); const int tid = tid_, wid = __builtin_amdgcn_readfirstlane(tid >> 6), lane = tid & 63, wr = wid >> 2, wc = wid & 3, fr = lane & 15, fq = lane >> 4;
    const int K = g.K, nt = K / BK;
    unsigned voffA[2], voffB[2];
#pragma unroll
    for (int i = 0; i < 2; ++i) { int R, C; stage_rc(tid * 16 + i * 8192, R, C); const int Rb = Epi::PERM ? ((R & ~31) + perm32(R & 31)) : R;
        voffA[i] = (unsigned)(R * K + C) * 2u; voffB[i] = (unsigned)(Rb * K + C) * 2u; }
    const size_t kstep = (size_t)(BK * 2);
    const size_t hstep = (size_t)HALF * K * 2;
    const size_t tstep = 2 * hstep;
    const unsigned ldsw = (unsigned)wid * 1024u;
    const int aoff = lds_byte(wr * 64 + fr, fq * 8), boff = lds_byte(wc * 32 + fr, fq * 8);
#define PG8_SA(b, h) (((b) * 2 + (h)) * HTB)
#define PG8_SB(b, h) ((4 + (b) * 2 + (h)) * HTB)
#define PG8_STAGE(bufoff, gbase, voff) do { _Pragma("unroll") for (int _i = 0; _i < 2; ++_i) \
        __builtin_amdgcn_global_load_lds((const unsigned*)((const char*)(gbase) + (voff)[_i]), (PG8_LAS unsigned*)(lds + (bufoff) + ldsw + _i * 8192), 16, 0, 0); } while (0)
#define PG8_LDA(dst, b, h) do { _Pragma("unroll") for (int m = 0; m < 4; ++m) _Pragma("unroll") for (int k = 0; k < 2; ++k) dst[m][k] = *(const PG8_LAS bf16x8*)(lds + PG8_SA(b, h) + aoff + m * 2048 + k * 1024); } while (0)
#define PG8_LDB(dst, b, h) do { _Pragma("unroll") for (int n = 0; n < 2; ++n) _Pragma("unroll") for (int k = 0; k < 2; ++k) dst[n][k] = *(const PG8_LAS bf16x8*)(lds + PG8_SB(b, h) + boff + n * 2048 + k * 1024); } while (0)
#define PG8_MMA(ai, bj, At, Bt) do { __builtin_amdgcn_s_setprio(1); _Pragma("unroll") for (int m = 0; m < 4; ++m) _Pragma("unroll") for (int n = 0; n < 2; ++n) _Pragma("unroll") for (int k = 0; k < 2; ++k) \
        acc[ai][bj][m][n] = __builtin_amdgcn_mfma_f32_16x16x32_bf16(Bt[n][k], At[m][k], acc[ai][bj][m][n], 0, 0, 0); __builtin_amdgcn_s_setprio(0); } while (0)
#define PG8_WAIT_V(n) asm volatile("s_waitcnt vmcnt(" #n ")" ::: "memory")
#define PG8_WAIT_L(n) asm volatile("s_waitcnt lgkmcnt(" #n ")" ::: "memory")
#define PG8_BAR __builtin_amdgcn_s_barrier()
#define PG8_SCHED __builtin_amdgcn_sched_barrier(0)
    Unit cur, nxt; int ui = 0;
    if (!S.next(0, cur)) return;
    f32x4 acc[2][2][4][2];
    typename Epi::Pre pre0 = E.issue(cur, wr, wc, fr, fq);
    bf16x8 At[4][2], B0[2][2], B1[2][2];
    const char* cA = (const char*)g.A + (size_t)cur.pm * tstep; const char* cB = (const char*)g.Bt + (size_t)cur.pn * tstep;
    S.a_ready(cur);
    if constexpr (SP2) {
        PG8_STAGE(PG8_SB(0, 0), cB, voffB); PG8_STAGE(PG8_SB(0, 1), cB + hstep, voffB); PG8_STAGE(PG8_SA(0, 0), cA, voffA); PG8_STAGE(PG8_SA(0, 1), cA + hstep, voffA);
        if (wr == 1) PG8_BAR;
        PG8_WAIT_V(2); PG8_BAR;
        PG8_STAGE(PG8_SB(1, 0), cB + kstep, voffB); PG8_STAGE(PG8_SA(1, 0), cA + kstep, voffA); PG8_STAGE(PG8_SB(1, 1), cB + hstep + kstep, voffB);
        PG8_WAIT_V(6); PG8_BAR;
    } else {
        PG8_STAGE(PG8_SB(0, 0), cB, voffB); PG8_STAGE(PG8_SA(0, 0), cA, voffA); PG8_STAGE(PG8_SB(0, 1), cB + hstep, voffB); PG8_STAGE(PG8_SA(0, 1), cA + hstep, voffA);
        if (wr == 1) PG8_BAR;
        PG8_WAIT_V(4); PG8_BAR;
        PG8_STAGE(PG8_SB(1, 0), cB + kstep, voffB); PG8_STAGE(PG8_SA(1, 0), cA + kstep, voffA); PG8_STAGE(PG8_SB(1, 1), cB + hstep + kstep, voffB);
        PG8_WAIT_V(6); PG8_BAR;
    }
    PG8_SCHED; E.finish(acc, pre0); PG8_SCHED;
    for (;;) {
        const bool has_next = S.next(ui + 1, nxt);
        const char* nA = has_next ? (const char*)g.A + (size_t)nxt.pm * tstep : cA; const char* nB = has_next ? (const char*)g.Bt + (size_t)nxt.pn * tstep : cB;
        for (int t = 0; t < nt; t += 2) {
            const bool last = (t == nt - 2);
            const char* a1 = cA + (size_t)(t + 1) * kstep;
            const char* a2 = last ? nA : cA + (size_t)(t + 2) * kstep; const char* b2 = last ? nB : cB + (size_t)(t + 2) * kstep;
            const char* a3 = a2 + kstep; const char* b3 = b2 + kstep;
            if (last && has_next) S.a_ready(nxt);
            if (last) E.pre(cur, wid, lane);
            if constexpr (SP2) {
            PG8_LDB(B0, 0, 0); PG8_LDB(B1, 0, 1); PG8_SCHED; PG8_LDA(At, 0, 0); PG8_STAGE(PG8_SA(1, 1), a1 + hstep, voffA);
            PG8_WAIT_V(8); PG8_WAIT_L(0); PG8_BAR; PG8_MMA(0, 0, At, B0); PG8_MMA(0, 1, At, B1); PG8_BAR; PG8_SCHED;
            PG8_LDA(At, 0, 1); PG8_STAGE(PG8_SB(0, 0), b2, voffB); PG8_STAGE(PG8_SB(0, 1), b2 + hstep, voffB); PG8_STAGE(PG8_SA(0, 0), a2, voffA);
            PG8_WAIT_V(8); PG8_WAIT_L(0); PG8_BAR; PG8_MMA(1, 0, At, B0); PG8_MMA(1, 1, At, B1); PG8_BAR; PG8_SCHED;
            PG8_LDB(B0, 1, 0); PG8_LDB(B1, 1, 1); PG8_SCHED; PG8_LDA(At, 1, 0); PG8_STAGE(PG8_SA(0, 1), a2 + hstep, voffA);
            PG8_WAIT_V(8); PG8_WAIT_L(0); PG8_BAR; PG8_MMA(0, 0, At, B0); PG8_MMA(0, 1, At, B1); PG8_BAR; PG8_SCHED;
            PG8_LDA(At, 1, 1); PG8_STAGE(PG8_SB(1, 0), b3, voffB); PG8_STAGE(PG8_SB(1, 1), b3 + hstep, voffB); PG8_STAGE(PG8_SA(1, 0), a3, voffA);
            PG8_WAIT_V(8); PG8_WAIT_L(0); PG8_BAR; PG8_MMA(1, 0, At, B0); PG8_MMA(1, 1, At, B1); PG8_BAR; PG8_SCHED;
            } else {
            PG8_LDB(B0, 0, 0); PG8_SCHED; PG8_LDA(At, 0, 0); PG8_STAGE(PG8_SA(1, 1), a1 + hstep, voffA);
            PG8_WAIT_L(8); PG8_BAR; PG8_WAIT_L(0); PG8_MMA(0, 0, At, B0); PG8_BAR; PG8_SCHED;
            PG8_LDB(B1, 0, 1); PG8_STAGE(PG8_SB(0, 0), b2, voffB);
            PG8_BAR; PG8_WAIT_L(0); PG8_MMA(0, 1, At, B1); PG8_BAR;
            PG8_LDA(At, 0, 1); PG8_STAGE(PG8_SA(0, 0), a2, voffA);
            PG8_BAR; PG8_WAIT_L(0); PG8_MMA(1, 0, At, B0); PG8_BAR; PG8_SCHED;
            PG8_STAGE(PG8_SB(0, 1), b2 + hstep, voffB);
            PG8_WAIT_V(6); PG8_BAR; PG8_MMA(1, 1, At, B1); PG8_BAR;
            PG8_LDB(B0, 1, 0); PG8_SCHED; PG8_LDA(At, 1, 0); PG8_STAGE(PG8_SA(0, 1), a2 + hstep, voffA);
            PG8_WAIT_L(8); PG8_BAR; PG8_WAIT_L(0); PG8_MMA(0, 0, At, B0); PG8_BAR; PG8_SCHED;
            PG8_LDB(B1, 1, 1); PG8_STAGE(PG8_SB(1, 0), b3, voffB);
            PG8_BAR; PG8_WAIT_L(0); PG8_MMA(0, 1, At, B1); PG8_BAR;
            PG8_LDA(At, 1, 1); PG8_STAGE(PG8_SA(1, 0), a3, voffA);
            PG8_BAR; PG8_WAIT_L(0); PG8_MMA(1, 0, At, B0); PG8_BAR; PG8_SCHED;
            PG8_STAGE(PG8_SB(1, 1), b3 + hstep, voffB);
            PG8_WAIT_V(6); PG8_BAR; PG8_MMA(1, 1, At, B1); PG8_BAR;
            }
        }
        if constexpr (ALIGN_EPI) { if (wr == 0) PG8_BAR; }
        if constexpr (!Epi::AFTER_DRAIN) { E(acc, cur, wr, wc, fr, fq); S.done(cur); }
        if (!has_next) break;
        { typename Epi::Pre pren = E.issue(nxt, wr, wc, fr, fq); E.finish(acc, pren); }
        cur = nxt; cA = nA; cB = nB; ++ui;
        if constexpr (ALIGN_EPI) { if (wr == 1) PG8_BAR; }
    }
    PG8_WAIT_V(0);
    if constexpr (!ALIGN_EPI) { if (wr == 0) PG8_BAR; }
    PG8_BAR;
    if constexpr (Epi::AFTER_DRAIN) { E.fused(acc, cur, wr, wc, fr, fq, lds, wid, lane); S.done(cur); }
#undef PG8_SA
#undef PG8_SB
#undef PG8_STAGE
#undef PG8_LDA
#undef PG8_LDB
#undef PG8_MMA
#undef PG8_WAIT_V
#undef PG8_WAIT_L
#undef PG8_BAR
#undef PG8_SCHED
}
}

#define LAS __attribute__((address_space(3)))
typedef unsigned short bf16;
typedef float f32x4 __attribute__((ext_vector_type(4)));
typedef float f32x2 __attribute__((ext_vector_type(2)));
typedef short bf16x8 __attribute__((ext_vector_type(8)));
typedef unsigned u32x4 __attribute__((ext_vector_type(4)));
typedef unsigned u32x2 __attribute__((ext_vector_type(2)));

constexpr int NTOK = 16384, SEQ = 8192, DM = 1024, FF = 2816, IW = 2816, NL = 4;
constexpr float EPS = 1e-6f;
constexpr int NTHR = 512, NWAVE = 8;
constexpr int LDS_BYTES = 155648;
constexpr int OFF_SSQL = 131072;

constexpr size_t MiB = 1u << 20;
constexpr size_t WS_CTL = 0;
constexpr size_t WS_ROPE = 1 * MiB;
constexpr size_t WS_SSQ = 5 * MiB;
constexpr size_t WS_S5E = 6 * MiB;
constexpr size_t WS_LRUC = 8 * MiB;
constexpr size_t WS_TAB = 9 * MiB;
constexpr size_t WS_W = 10 * MiB;
constexpr size_t WL_STRIDE = 43 * MiB;
constexpr size_t WL_GU1 = 0, WL_D1 = 11534336, WL_WIN = WL_D1 + 5767168, WL_WOUT = WL_WIN + 5767168, WL_GU2 = WL_WOUT + 2097152,
                 WL_D2 = WL_GU2 + 11534336, WL_GLU = WL_D2 + 5767168, WL_WA = WL_GLU + 131072, WL_WX = WL_WA + 32768, WL_CM = WL_WX + 32768,
                 WL_S5T = WL_CM + 65536, WL_BB = WL_S5T + 147456, WL_END = WL_BB + 65536;
static_assert(WL_END <= WL_STRIDE, "weights per layer");
constexpr size_t WS_XB = 182 * MiB;
constexpr size_t WS_HZ = 214 * MiB;
constexpr size_t WS_Y = 302 * MiB;
constexpr size_t WS_KV = 334 * MiB;
constexpr size_t WS_PB = 366 * MiB;
constexpr size_t WS_END = 382 * MiB;

struct Args { const float* in[33]; float* out; unsigned char* ws; };

#define XB_TMO      128
#define XB_XCNT(j)  (256  + 64 * (j))
#define XB_XSUB(j)  (1280 + 64 * (j))
#define XB_XGEN(j)  (2304 + 64 * (j))
#define XB_TOP      3328
#define XB_TOPGEN   3392
#define XCD_BAR_WORDS 3456
#define XB_SPIN_CAP (1u << 18)

__device__ __forceinline__ unsigned xb_ld(unsigned* p)              { return __hip_atomic_load(p, __ATOMIC_RELAXED, __HIP_MEMORY_SCOPE_AGENT); }
__device__ __forceinline__ unsigned xb_add(unsigned* p, unsigned v) { return __hip_atomic_fetch_add(p, v, __ATOMIC_RELAXED, __HIP_MEMORY_SCOPE_AGENT); }
__device__ __forceinline__ unsigned xb_xcc_id() { return (unsigned)__builtin_amdgcn_s_getreg((3 << 11) | 20) & 0xFu; }
#define XB_SPIN(cond, bar) do { unsigned _sp = 0; while (cond) { __builtin_amdgcn_s_sleep(1); \
    if ((++_sp & 255u) == 0u) { if (xb_ld(&(bar)[XB_TMO])) break; if (_sp > XB_SPIN_CAP) { atomicAdd(&(bar)[XB_TMO], 1u); break; } } } } while (0)

struct XcdBarrier {
    unsigned* bar; unsigned x;
    volatile LAS unsigned* st;
};

__device__ __forceinline__ XcdBarrier xcd_barrier_post(unsigned* bar, volatile LAS unsigned* st) {
    XcdBarrier b; b.bar = bar; b.x = xb_xcc_id(); b.st = st;
    if (threadIdx.x == 0) (void)xb_add(&bar[XB_XCNT(b.x)], 1u);
    return b;
}
__device__ __forceinline__ void xcd_barrier_complete(unsigned* bar, unsigned x, unsigned& nloc, unsigned& nx) {
    const unsigned G = gridDim.x * gridDim.y * gridDim.z;
    unsigned sum, cnt, mine, sp = 0u;
    for (;;) {
        sum = 0u; cnt = 0u; mine = 0u;
#pragma unroll
        for (unsigned j = 0; j < 16; ++j) { const unsigned c = xb_ld(&bar[XB_XCNT(j)]); sum += c; cnt += (c > 0u) ? 1u : 0u; mine = (j == x) ? c : mine; }
        if (sum == G) break;
        __builtin_amdgcn_s_sleep(1);
        if ((++sp & 255u) == 0u) { if (xb_ld(&bar[XB_TMO])) break; if (sp > XB_SPIN_CAP) { atomicAdd(&bar[XB_TMO], 1u); break; } }
    }
    nloc = mine > 0u ? mine : 1u; nx = cnt > 0u ? cnt : 1u;
}

__device__ __forceinline__ void xcd_barrier(const XcdBarrier& b) {
    asm volatile("s_waitcnt vmcnt(0)" ::: "memory");
    __syncthreads();
    if (threadIdx.x == 0) {
        unsigned* bar = b.bar;
        __builtin_amdgcn_s_waitcnt(0);
        unsigned nloc = b.st[0], nx = b.st[1];
        if (nloc == 0u) { xcd_barrier_complete(bar, b.x, nloc, nx); b.st[0] = nloc; b.st[1] = nx; }
        const unsigned old = xb_add(&bar[XB_XSUB(b.x)], 1u);
        const unsigned gen = old / nloc;
        if (old + 1u == (gen + 1u) * nloc) {
            __builtin_amdgcn_fence(__ATOMIC_RELEASE, "agent");
            asm volatile("s_waitcnt vmcnt(0)" ::: "memory");
            const unsigned og = xb_add(&bar[XB_TOP], 1u);
            const unsigned tg = og / nx;
            if (og + 1u == (tg + 1u) * nx) xb_add(&bar[XB_TOPGEN], 1u);
            else XB_SPIN(xb_ld(&bar[XB_TOPGEN]) == tg, bar);
            __builtin_amdgcn_fence(__ATOMIC_ACQUIRE, "agent");
            xb_add(&bar[XB_XGEN(b.x)], 1u);
            asm volatile("s_waitcnt vmcnt(0)" ::: "memory");
        } else {
            XB_SPIN(xb_ld(&bar[XB_XGEN(b.x)]) == gen, bar);
            __builtin_amdgcn_fence(__ATOMIC_ACQUIRE, "agent");
            asm volatile("s_waitcnt vmcnt(0)" ::: "memory");
        }
    }
    __syncthreads();
}

constexpr int MISC_OFF = LDS_BYTES - 64;
constexpr int CW_BAR = 4096;

__device__ __forceinline__ float bf2f(unsigned v) { return __uint_as_float(v << 16); }
__device__ __forceinline__ unsigned pk2(float lo, float hi) { return pg8::cvt_pk_bf16(lo, hi); }
__device__ __forceinline__ float sigmoidf_(float x) { return __builtin_amdgcn_rcpf(1.0f + __expf(-x)); }
__device__ __forceinline__ float siluf_(float x) { return x * sigmoidf_(x); }
__device__ __forceinline__ float geluf_(float x) { const float z = 1.5957691216057308f * (x + 0.044715f * x * x * x); return x * sigmoidf_(z); }
__device__ __forceinline__ void lds_wait() { asm volatile("s_waitcnt lgkmcnt(0)" ::: "memory"); }
__device__ __forceinline__ void unpack8(u32x4 v, float* f) {
    f[0] = __uint_as_float(v.x << 16); f[1] = __uint_as_float(v.x & 0xffff0000u); f[2] = __uint_as_float(v.y << 16); f[3] = __uint_as_float(v.y & 0xffff0000u);
    f[4] = __uint_as_float(v.z << 16); f[5] = __uint_as_float(v.z & 0xffff0000u); f[6] = __uint_as_float(v.w << 16); f[7] = __uint_as_float(v.w & 0xffff0000u);
}
__device__ __forceinline__ float row_rstd(const float* ssq, int row) {
    const f32x4* p = (const f32x4*)(ssq + (size_t)row * 16);
    const f32x4 a = p[0], b = p[1], c = p[2], d = p[3];
    const float s = ((a.x + a.y) + (a.z + a.w)) + ((b.x + b.y) + (b.z + b.w)) + ((c.x + c.y) + (c.z + c.w)) + ((d.x + d.y) + (d.z + d.w));
    return rsqrtf(s * (1.0f / DM) + EPS);
}
__device__ __forceinline__ void rows_rstd(LAS unsigned char* sl, int rl0, int fq, float (&rs)[8]) {
    f32x4 v[8];
#pragma unroll
    for (int i = 0; i < 8; ++i) v[i] = *(const LAS f32x4*)(sl + (rl0 + (i >> 2) * 128 + (i & 3) * 16) * 64 + fq * 16);
#pragma unroll
    for (int i = 0; i < 8; ++i) { float s = (v[i].x + v[i].y) + (v[i].z + v[i].w); s += __shfl_xor(s, 16); s += __shfl_xor(s, 32); rs[i] = rsqrtf(s * (1.0f / DM) + EPS); }
}
#define MFMA16(X, Y, ACC) ACC = __builtin_amdgcn_mfma_f32_16x16x32_bf16(X, Y, ACC, 0, 0, 0)

struct EpiGU {
    static constexpr bool PERM = true, AFTER_DRAIN = false;
    bf16* H; const float* ssq;
    struct Pre {};
    __device__ __forceinline__ Pre issue(const pg8::Unit&, int, int, int, int) const { return Pre{}; }
    __device__ __forceinline__ void finish(f32x4 (&acc)[2][2][4][2], const Pre&) const {
#pragma unroll
        for (int a = 0; a < 2; ++a)
#pragma unroll
            for (int b = 0; b < 2; ++b)
#pragma unroll
                for (int m = 0; m < 4; ++m)
#pragma unroll
                    for (int n = 0; n < 2; ++n) acc[a][b][m][n] = (f32x4){0.f, 0.f, 0.f, 0.f};
    }
    LAS unsigned char* sl;
    __device__ __forceinline__ void pre(const pg8::Unit& u, int wid, int lane) const {
#pragma unroll
        for (int i = 0; i < 2; ++i) __builtin_amdgcn_global_load_lds((const unsigned*)(ssq + (size_t)(u.pm * 256 + wid * 32 + i * 16 + (lane >> 2)) * 16 + (lane & 3) * 4), (LAS unsigned*)(sl + (wid * 32 + i * 16) * 64), 16, 0, 0);
    }
    __device__ __forceinline__ void operator()(const f32x4 (&acc)[2][2][4][2], const pg8::Unit& u, int wr, int wc, int fr, int fq) const {
        const int row0 = u.pm * 256 + wr * 64 + fr, col0 = u.pn * 128 + wc * 32 + 8 * fq;
        float rs[8]; rows_rstd(sl, wr * 64 + fr, fq, rs);
#pragma unroll
        for (int ai = 0; ai < 2; ++ai)
#pragma unroll
            for (int m = 0; m < 4; ++m) {
                const int row = row0 + ai * 128 + m * 16; const float r = rs[ai * 4 + m];
                float h[8];
#pragma unroll
                for (int n = 0; n < 2; ++n)
#pragma unroll
                    for (int j = 0; j < 4; ++j) { const float g = acc[ai][0][m][n][j] * r, up = acc[ai][1][m][n][j] * r; h[n * 4 + j] = siluf_(g) * up; }
                u32x4 w; w.x = pk2(h[0], h[1]); w.y = pk2(h[2], h[3]); w.z = pk2(h[4], h[5]); w.w = pk2(h[6], h[7]);
                *(u32x4*)(H + (size_t)row * FF + col0) = w;
            }
    }
};
struct EpiRes {
    static constexpr bool PERM = true, AFTER_DRAIN = false;
    bf16* XB; float* ssq; float alpha, inv_alpha;
    struct Pre { u32x4 v[2][4][2]; };
    __device__ __forceinline__ void pre(const pg8::Unit&, int, int) const {}
    __device__ __forceinline__ Pre issue(const pg8::Unit& u, int wr, int wc, int fr, int fq) const {
        Pre p; const int row0 = u.pm * 256 + wr * 64 + fr, colb = u.pn * 256 + wc * 32 + 8 * fq;
#pragma unroll
        for (int ai = 0; ai < 2; ++ai)
#pragma unroll
            for (int m = 0; m < 4; ++m)
#pragma unroll
                for (int bj = 0; bj < 2; ++bj) p.v[ai][m][bj] = *(const u32x4*)(XB + (size_t)(row0 + ai * 128 + m * 16) * DM + colb + bj * 128);
        return p;
    }
    __device__ __forceinline__ void finish(f32x4 (&acc)[2][2][4][2], const Pre& p) const {
#pragma unroll
        for (int ai = 0; ai < 2; ++ai)
#pragma unroll
            for (int m = 0; m < 4; ++m)
#pragma unroll
                for (int bj = 0; bj < 2; ++bj) { float f[8]; unpack8(p.v[ai][m][bj], f);
                    acc[ai][bj][m][0] = (f32x4){f[0], f[1], f[2], f[3]} * inv_alpha; acc[ai][bj][m][1] = (f32x4){f[4], f[5], f[6], f[7]} * inv_alpha; }
    }
    __device__ __forceinline__ void operator()(const f32x4 (&acc)[2][2][4][2], const pg8::Unit& u, int wr, int wc, int fr, int fq) const {
        const int row0 = u.pm * 256 + wr * 64 + fr, colb = u.pn * 256 + wc * 32 + 8 * fq;
#pragma unroll
        for (int ai = 0; ai < 2; ++ai)
#pragma unroll
            for (int m = 0; m < 4; ++m) {
                const int row = row0 + ai * 128 + m * 16;
                float ss = 0.f;
#pragma unroll
                for (int bj = 0; bj < 2; ++bj) {
                    const f32x4 x0 = acc[ai][bj][m][0] * alpha, x1 = acc[ai][bj][m][1] * alpha;
                    u32x4 w; w.x = pk2(x0.x, x0.y); w.y = pk2(x0.z, x0.w); w.z = pk2(x1.x, x1.y); w.w = pk2(x1.z, x1.w);
                    *(u32x4*)(XB + (size_t)row * DM + colb + bj * 128) = w;
                    ss += (x0.x * x0.x + x0.y * x0.y) + (x0.z * x0.z + x0.w * x0.w) + (x1.x * x1.x + x1.y * x1.y) + (x1.z * x1.z + x1.w * x1.w);
                }
                ss += __shfl_xor(ss, 16); ss += __shfl_xor(ss, 32);
                if (fq == 0) ssq[(size_t)row * 16 + u.pn * 4 + wc] = ss;
            }
    }
};
struct EpiWin {
    static constexpr bool PERM = true, AFTER_DRAIN = false;
    bf16* Z; const float* ssq; const float* rcos; const float* rsin;
    struct Pre {};
    __device__ __forceinline__ Pre issue(const pg8::Unit&, int, int, int, int) const { return Pre{}; }
    __device__ __forceinline__ void finish(f32x4 (&acc)[2][2][4][2], const Pre&) const {
#pragma unroll
        for (int a = 0; a < 2; ++a)
#pragma unroll
            for (int b = 0; b < 2; ++b)
#pragma unroll
                for (int m = 0; m < 4; ++m)
#pragma unroll
                    for (int n = 0; n < 2; ++n) acc[a][b][m][n] = (f32x4){0.f, 0.f, 0.f, 0.f};
    }
    LAS unsigned char* sl;
    __device__ __forceinline__ void pre(const pg8::Unit& u, int wid, int lane) const {
#pragma unroll
        for (int i = 0; i < 2; ++i) __builtin_amdgcn_global_load_lds((const unsigned*)(ssq + (size_t)(u.pm * 256 + wid * 32 + i * 16 + (lane >> 2)) * 16 + (lane & 3) * 4), (LAS unsigned*)(sl + (wid * 32 + i * 16) * 64), 16, 0, 0);
    }
    __device__ __forceinline__ void operator()(const f32x4 (&acc)[2][2][4][2], const pg8::Unit& u, int wr, int wc, int fr, int fq) const {
        const int row0 = u.pm * 256 + wr * 64 + fr, pn = u.pn;
        float rs[8]; rows_rstd(sl, wr * 64 + fr, fq, rs);
        if (pn >= 1 && pn <= 4) {
            const float qs = (pn <= 2) ? 0.08838834764831845f : 1.0f;
            const int dd0 = 32 * (wc & 1) + 8 * fq, hh = wc >> 1;
#pragma unroll
            for (int ab = 0; ab < 4; ++ab) { const int ai = ab >> 1, mb = (ab & 1) * 2;
                f32x4 cs[4][4];
#pragma unroll
                for (int m = mb; m < mb + 2; ++m) { const int pos = (row0 + ai * 128 + m * 16) & (SEQ - 1); const float* cp = rcos + pos * 64 + dd0; const float* sp = rsin + pos * 64 + dd0;
                    cs[m][0] = *(const f32x4*)cp; cs[m][1] = *(const f32x4*)(cp + 4); cs[m][2] = *(const f32x4*)sp; cs[m][3] = *(const f32x4*)(sp + 4); }
#pragma unroll
                for (int m = mb; m < mb + 2; ++m) {
                    const int row = row0 + ai * 128 + m * 16; const float r = rs[ai * 4 + m] * qs;
                    const f32x4 c0 = cs[m][0], c1 = cs[m][1], s0 = cs[m][2], s1 = cs[m][3];
                    const f32x4 ta = acc[ai][0][m][0] * r, tb = acc[ai][0][m][1] * r, ua = acc[ai][1][m][0] * r, ub = acc[ai][1][m][1] * r;
                    const f32x4 o1a = ta * c0 - ua * s0, o1b = tb * c1 - ub * s1, o2a = ta * s0 + ua * c0, o2b = tb * s1 + ub * c1;
                    bf16* zp = Z + (size_t)row * IW + pn * 256 + hh * 128 + dd0;
                    u32x4 w1, w2;
                    w1.x = pk2(o1a.x, o1a.y); w1.y = pk2(o1a.z, o1a.w); w1.z = pk2(o1b.x, o1b.y); w1.w = pk2(o1b.z, o1b.w);
                    w2.x = pk2(o2a.x, o2a.y); w2.y = pk2(o2a.z, o2a.w); w2.z = pk2(o2b.x, o2b.y); w2.w = pk2(o2b.z, o2b.w);
                    *(u32x4*)zp = w1; *(u32x4*)(zp + 64) = w2;
                }
                asm volatile("" ::: "memory");
            }
        } else {
            const int act = (pn == 7 || pn == 8) ? 1 : (pn == 10 ? 2 : 0);
#pragma unroll
            for (int ai = 0; ai < 2; ++ai)
#pragma unroll
                for (int m = 0; m < 4; ++m) {
                    const int row = row0 + ai * 128 + m * 16; const float r = rs[ai * 4 + m];
#pragma unroll
                    for (int bj = 0; bj < 2; ++bj) {
                        float v[8];
#pragma unroll
                        for (int n = 0; n < 2; ++n)
#pragma unroll
                            for (int j = 0; j < 4; ++j) { float t = acc[ai][bj][m][n][j] * r; if (act == 1) t = siluf_(t); else if (act == 2) t = geluf_(t); v[n * 4 + j] = t; }
                        u32x4 w; w.x = pk2(v[0], v[1]); w.y = pk2(v[2], v[3]); w.z = pk2(v[4], v[5]); w.w = pk2(v[6], v[7]);
                        *(u32x4*)(Z + (size_t)row * IW + pn * 256 + bj * 128 + wc * 32 + 8 * fq) = w;
                    }
                }
        }
    }
};

__device__ __forceinline__ void transpose_item(const float* W, int N, bf16* WT, int K, int k0, int n0, int drow0, const float* gk, LAS float* scr, int lane) {
    float wv[32];
#pragma unroll
    for (int i = 0; i < 32; ++i) wv[i] = W[(size_t)(k0 + 2 * i + (lane >> 5)) * N + n0 + (lane & 31)];
#pragma unroll
    for (int i = 0; i < 32; ++i) { const int kk = 2 * i + (lane >> 5); float v = wv[i]; if (gk) v *= gk[kk]; scr[kk * 33 + (lane & 31)] = v; }
    lds_wait();
    const int c = lane & 7;
#pragma unroll
    for (int j = 0; j < 4; ++j) { const int n = (lane >> 3) + 8 * j; const LAS float* s = scr + (8 * c) * 33 + n;
        u32x4 o; o.x = pk2(s[0 * 33], s[1 * 33]); o.y = pk2(s[2 * 33], s[3 * 33]); o.z = pk2(s[4 * 33], s[5 * 33]); o.w = pk2(s[6 * 33], s[7 * 33]);
        *(u32x4*)(WT + (size_t)(drow0 + n) * K + k0 + 8 * c) = o; }
    lds_wait();
}
constexpr int IT_BIG = 1408, IT_OUT = 512, IT_GLU = 32, IT_LW = 8;
constexpr int IT_LAYER = 7 * IT_BIG + IT_OUT + IT_GLU + 2 * IT_LW;
__device__ __forceinline__ void p0_weight_item(const Args& a, int l, int r, LAS float* scr, int lane) {
    unsigned char* wl = a.ws + WS_W + (size_t)l * WL_STRIDE;
#pragma unroll
    for (int f = 0; f < 2; ++f) {
        const float* nrm = a.in[f ? 28 : 1] + (size_t)l * DM;
        bf16* gu = (bf16*)(wl + (f ? WL_GU2 : WL_GU1)); bf16* dn = (bf16*)(wl + (f ? WL_D2 : WL_D1));
        if (r < 2 * IT_BIG) { const int up = r >= IT_BIG; const int it = r - up * IT_BIG; const int kb = it / 88, nb = it % 88, k0 = 64 * kb, n0 = 32 * nb;
            const float* W = a.in[(f ? 29 : 2) + up] + (size_t)l * DM * FF;
            transpose_item(W, FF, gu, DM, k0, n0, (n0 >> 7) * 256 + up * 128 + (n0 & 127), nrm + k0, scr, lane); return; }
        r -= 2 * IT_BIG;
        if (r < IT_BIG) { const int kb = r / 32, nb = r % 32; const float* W = a.in[f ? 31 : 4] + (size_t)l * FF * DM;
            transpose_item(W, DM, dn, FF, 64 * kb, 32 * nb, 32 * nb, nullptr, scr, lane); return; }
        r -= IT_BIG;
    }
    if (r < IT_BIG) {
        const int kb = r / 88, nb = r % 88, k0 = 64 * kb, n0 = 32 * nb; const int tile = n0 >> 8, c0 = n0 & 255;
        int drow = n0;
        if (tile >= 1 && tile <= 4) { const int hh = c0 >> 7, d0 = c0 & 127, bj = d0 >> 6, dd0 = d0 & 63; drow = tile * 256 + bj * 128 + hh * 64 + dd0; }
        transpose_item(a.in[6] + (size_t)l * DM * IW, IW, (bf16*)(wl + WL_WIN), DM, k0, n0, drow, a.in[5] + (size_t)l * DM + k0, scr, lane); return; }
    r -= IT_BIG;
    if (r < IT_OUT) {
        const int kb = r / 32, nb = r % 32, k0 = 64 * kb;
        const float* gk = (k0 < 256) ? a.in[17] + (size_t)l * 256 + k0 : (k0 < 768 ? a.in[18] + (size_t)l * 512 + (k0 - 256) : a.in[26] + (size_t)l * 256 + (k0 - 768));
        transpose_item(a.in[27] + (size_t)l * DM * DM, DM, (bf16*)(wl + WL_WOUT), DM, k0, 32 * nb, 32 * nb, gk, scr, lane); return; }
    r -= IT_OUT;
    if (r < IT_GLU) { const int kb = r / 8, nb = r % 8; transpose_item(a.in[15] + (size_t)l * 65536, 256, (bf16*)(wl + WL_GLU), 256, 64 * kb, 32 * nb, 32 * nb, nullptr, scr, lane); return; }
    r -= IT_GLU;
    if (r < IT_LW) { const int blk = r >> 1, nb = r & 1; transpose_item(a.in[21] + (size_t)l * 16384 + blk * 4096, 64, (bf16*)(wl + WL_WA) + blk * 4096, 64, 0, 32 * nb, 32 * nb, nullptr, scr, lane); return; }
    r -= IT_LW;
    { const int blk = r >> 1, nb = r & 1; transpose_item(a.in[23] + (size_t)l * 16384 + blk * 4096, 64, (bf16*)(wl + WL_WX) + blk * 4096, 64, 0, 32 * nb, 32 * nb, nullptr, scr, lane); }
}
__device__ __forceinline__ float wave_sum(float v) {
#pragma unroll
    for (int o = 1; o < 64; o <<= 1) v += __shfl_xor(v, o);
    return v;
}
__device__ __forceinline__ void p0_prologue(const Args& a, LAS unsigned char* lds, int tid, int lane, int wave, int G) {
    LAS float* scr = (LAS float*)(lds + wave * 8448);
    const int gw = blockIdx.x * NWAVE + wave, NGW = G * NWAVE;
    for (int it = gw; it < (G == 256 ? 1 : NL) * IT_LAYER; it += NGW) p0_weight_item(a, it / IT_LAYER, it % IT_LAYER, scr, lane);
    const float* x = a.in[0]; bf16* xb = (bf16*)(a.ws + WS_XB); float* ssq = (float*)(a.ws + WS_SSQ);
    for (int m = gw; m < NTOK; m += NGW) {
        const f32x4* xr = (const f32x4*)(x + (size_t)m * DM) + lane; u32x2* brow = (u32x2*)(xb + (size_t)m * DM) + lane;
        float s = 0.f;
#pragma unroll
        for (int j = 0; j < 4; ++j) { const f32x4 v = xr[64 * j]; u32x2 w; w.x = pk2(v.x, v.y); w.y = pk2(v.z, v.w); brow[64 * j] = w; s += (v.x * v.x + v.y * v.y) + (v.z * v.z + v.w * v.w); }
        s = wave_sum(s);
        if (lane < 16) ssq[(size_t)m * 16 + lane] = (lane == 0) ? s : 0.f;
    }
    const int gt = blockIdx.x * NTHR + tid, NGT = G * NTHR;
    float* rcos = (float*)(a.ws + WS_ROPE); float* rsin = rcos + SEQ * 64;
    for (int i = gt; i < SEQ * 64; i += NGT) { const int pos = i >> 6, k = i & 63; const float inv = powf(10000.0f, -(float)(2 * k) / 128.0f); const float ang = (float)pos * inv; rcos[i] = cosf(ang); rsin[i] = sinf(ang); }
    for (int i = gt; i < NL * 16 * 64; i += NGT) {
        const int p = i & 63, lg = i >> 6, l = lg >> 4, g = lg & 15;
        const float lre = a.in[7][i], lim = a.in[8][i], step = expf(a.in[9][lg]);
        const float ar = lre * step, ai = lim * step, mag = expf(ar), lbr = mag * cosf(ai), lbi = mag * sinf(ai);
        const float nr = lbr - 1.0f, den = lre * lre + lim * lim, fr = (nr * lre + lbi * lim) / den, fi = (lbi * lre - nr * lim) / den;
        float* tab = (float*)(a.ws + WS_W + (size_t)l * WL_STRIDE + WL_S5T) + (size_t)g * 36 * 64 + p;
        float cr = lbr, ci = lbi;
#pragma unroll
        for (int q = 0; q < 6; ++q) { const float t = cr * cr - ci * ci; ci = 2.0f * cr * ci; cr = t; }
        tab[0] = lbr; tab[64] = lbi; tab[128] = cr; tab[192] = ci;
        for (int h = 0; h < 16; ++h) { const float br = a.in[10][(size_t)i * 16 + h], bi = a.in[11][(size_t)i * 16 + h]; const float bbr = fr * br - fi * bi, bbi = fr * bi + fi * br; tab[(4 + h) * 64] = bbr; tab[(20 + h) * 64] = bbi;
            bf16* BB = (bf16*)(a.ws + WS_W + (size_t)l * WL_STRIDE + WL_BB); const unsigned pr = pk2(bbr, bbi);
            BB[(size_t)(g * 128 + p) * 16 + h] = (bf16)(pr & 0xffffu); BB[(size_t)(g * 128 + 64 + p) * 16 + h] = (bf16)(pr >> 16); }
    }
    for (int i = gt; i < NL * 16 * 16 * 128; i += NGT) {
        const int k = i & 127, lgh = i >> 7, l = lgh >> 8;
        const float v = (k < 64) ? a.in[12][(size_t)lgh * 64 + k] : -a.in[13][(size_t)lgh * 64 + (k - 64)];
        ((bf16*)(a.ws + WS_W + (size_t)l * WL_STRIDE + WL_CM))[i & 32767] = (bf16)(pk2(v, 0.f) & 0xffffu);
    }
    for (int i = gt; i < NL * 256; i += NGT) { const float lam = a.in[25][i]; const float sp = (lam > 15.f) ? expf(-lam) : log1pf(expf(-lam)); ((float*)(a.ws + WS_TAB))[i] = -8.0f * sp; }
}

__device__ __forceinline__ void tail_convert(const Args& a, int l, int slot, LAS unsigned char* lds) {
    if (l >= NL) return;
    int tid = threadIdx.x; asm volatile("" : "+v"(tid)); const int lane = tid & 63, wave = __builtin_amdgcn_readfirstlane(tid >> 6);
    LAS float* scr = (LAS float*)(lds + wave * 8448);
    for (int it = slot * NWAVE + wave; it < IT_LAYER; it += 320 * NWAVE) p0_weight_item(a, l, it, scr, lane);
    __syncthreads();
}
constexpr int OFF_BUS = 0, BUS_WAVE = 8448, OFF_SST = 67584, SST_WAVE = 4352, OFF_YS = 102400, OFF_RED2 = 136192;
template <bool FULL> __device__ __forceinline__ void s5_group(const Args& a, int l, int tile, int g, LAS unsigned char* lds, int lane, int wave) {
    const bf16* Z = (const bf16*)(a.ws + WS_HZ);
    const int t0 = tile * 64, fr = lane & 15, fq = lane >> 4;
    unsigned char* wl = a.ws + WS_W + (size_t)l * WL_STRIDE;
    const float* tab = (const float*)(wl + WL_S5T) + (size_t)g * 36 * 64; const bf16* BB = (const bf16*)(wl + WL_BB); const bf16* CM = (const bf16*)(wl + WL_CM);
    float* E = (float*)(a.ws + WS_S5E);
    LAS unsigned char* bus = lds + OFF_BUS + wave * BUS_WAVE; LAS unsigned char* sst = lds + OFF_SST + wave * SST_WAVE;
    const float lbr = tab[lane], lbi = tab[64 + lane];
    const bf16x8 zero8 = {0, 0, 0, 0, 0, 0, 0, 0};
    bf16x8 bbf[8];
#pragma unroll
    for (int kt = 0; kt < 8; ++kt) { bbf[kt] = zero8; if (fq < 2) bbf[kt] = *(const bf16x8*)(BB + (size_t)(g * 128 + kt * 16 + fr) * 16 + 8 * fq); }
    float sre = 0.f, sim = 0.f;
    bf16x8 cm[4]; f32x4 dsk;
    if (FULL) {
        sre = E[((size_t)(tile * 16 + g) * 2 + 0) * 64 + lane]; sim = E[((size_t)(tile * 16 + g) * 2 + 1) * 64 + lane];
#pragma unroll
        for (int ks = 0; ks < 4; ++ks) cm[ks] = *(const bf16x8*)(CM + (size_t)(g * 16 + fr) * 128 + 32 * ks + 8 * fq);
        dsk = *(const f32x4*)(a.in[14] + (size_t)l * 256 + g * 16 + 4 * fq);
    }
    bf16x8 ufa[4]; u32x2 urawa[4];
#pragma unroll
    for (int tb = 0; tb < 4; ++tb) { const bf16* zr = Z + (size_t)(t0 + tb * 16 + fr) * IW + g * 16;
        ufa[tb] = zero8; if (fq < 2) ufa[tb] = *(const bf16x8*)(zr + 8 * fq);
        if (FULL) urawa[tb] = *(const u32x2*)(zr + 4 * fq); }
#pragma unroll
    for (int tb = 0; tb < 4; ++tb) {
        const bf16x8 uf = ufa[tb]; u32x2 uraw; if (FULL) uraw = urawa[tb];
#pragma unroll
        for (int kt = 0; kt < 8; ++kt) { f32x4 d = {0.f, 0.f, 0.f, 0.f}; MFMA16(bbf[kt], uf, d); *(LAS f32x4*)(bus + (fr * 132 + kt * 16 + 4 * fq) * 4) = d; }
        lds_wait();
        float bra[16], bia[16];
#pragma unroll
        for (int tt = 0; tt < 16; ++tt) { bra[tt] = *(const LAS float*)(bus + (tt * 132 + lane) * 4); bia[tt] = *(const LAS float*)(bus + (tt * 132 + 64 + lane) * 4); }
#pragma unroll
        for (int tt = 0; tt < 16; ++tt) {
            const float br = bra[tt], bi = bia[tt];
            const float nre = lbr * sre - lbi * sim + br, nim = lbr * sim + lbi * sre + bi; sre = nre; sim = nim;
            if (FULL) { const unsigned pr = pk2(sre, sim);
                *(LAS bf16*)(sst + (tt * 136 + lane) * 2) = (bf16)(pr & 0xffffu); *(LAS bf16*)(sst + (tt * 136 + 64 + lane) * 2) = (bf16)(pr >> 16); }
        }
        if (FULL) {
            lds_wait();
            f32x4 acc = {0.f, 0.f, 0.f, 0.f};
#pragma unroll
            for (int ks = 0; ks < 4; ++ks) { const bf16x8 yv = *(const LAS bf16x8*)(sst + (fr * 136 + 32 * ks + 8 * fq) * 2); MFMA16(cm[ks], yv, acc); }
            const int t = tb * 16 + fr;
            f32x4 u4; u4.x = __uint_as_float(uraw.x << 16); u4.y = __uint_as_float(uraw.x & 0xffff0000u); u4.z = __uint_as_float(uraw.y << 16); u4.w = __uint_as_float(uraw.y & 0xffff0000u);
            const f32x4 v = acc + dsk * u4;
            u32x2 w; w.x = pk2(geluf_(v.x), geluf_(v.y)); w.y = pk2(geluf_(v.z), geluf_(v.w));
            *(LAS u32x2*)(lds + OFF_YS + (t * 264 + g * 16 + 4 * fq) * 2) = w;
        }
        lds_wait();
    }
    if (!FULL) { E[((size_t)(tile * 16 + g) * 2 + 0) * 64 + lane] = sre; E[((size_t)(tile * 16 + g) * 2 + 1) * 64 + lane] = sim; }
}
__device__ __forceinline__ void s5_m1(const Args& a, int l, int tile, LAS unsigned char* lds, int tid, int lane, int wave) {
    for (int gi = 0; gi < 2; ++gi) s5_group<false>(a, l, tile, wave * 2 + gi, lds, lane, wave);
    __syncthreads();
}
__device__ __forceinline__ void s5_m3(const Args& a, int l, int tile, LAS unsigned char* lds, int tid, int lane, int wave) {
    bf16* Y = (bf16*)(a.ws + WS_Y);
    const int t0 = tile * 64, fr = lane & 15, fq = lane >> 4;
    unsigned char* wl = a.ws + WS_W + (size_t)l * WL_STRIDE;
    for (int gi = 0; gi < 2; ++gi) s5_group<true>(a, l, tile, wave * 2 + gi, lds, lane, wave);
    __syncthreads();
    {
        const int cb = wave & 3, jh = wave >> 2; const bf16* WG = (const bf16*)(wl + WL_GLU);
        f32x4 acc[8];
#pragma unroll
        for (int jt = 0; jt < 8; ++jt) acc[jt] = (f32x4){0.f, 0.f, 0.f, 0.f};
#pragma unroll
        for (int ks = 0; ks < 8; ++ks) {
            const bf16x8 yv = *(const LAS bf16x8*)(lds + OFF_YS + ((cb * 16 + fr) * 264 + 32 * ks + 8 * fq) * 2);
#pragma unroll
            for (int jt = 0; jt < 8; ++jt) { const bf16x8 wv = *(const bf16x8*)(WG + (size_t)(jh * 128 + jt * 16 + fr) * 256 + 32 * ks + 8 * fq); MFMA16(wv, yv, acc[jt]); }
        }
        const int t = cb * 16 + fr; float ss = 0.f;
#pragma unroll
        for (int jt = 0; jt < 8; ++jt) {
            const int j0 = jh * 128 + jt * 16 + 4 * fq;
            const f32x4 bg = *(const f32x4*)(a.in[16] + (size_t)l * 256 + j0);
            const u32x2 yr = *(const LAS u32x2*)(lds + OFF_YS + (t * 264 + j0) * 2);
            f32x4 o;
            o.x = __uint_as_float(yr.x << 16) * sigmoidf_(acc[jt].x + bg.x); o.y = __uint_as_float(yr.x & 0xffff0000u) * sigmoidf_(acc[jt].y + bg.y);
            o.z = __uint_as_float(yr.y << 16) * sigmoidf_(acc[jt].z + bg.z); o.w = __uint_as_float(yr.y & 0xffff0000u) * sigmoidf_(acc[jt].w + bg.w);
            acc[jt] = o; ss += (o.x * o.x + o.y * o.y) + (o.z * o.z + o.w * o.w);
        }
        ss += __shfl_xor(ss, 16); ss += __shfl_xor(ss, 32);
        LAS float* red = (LAS float*)(lds + OFF_RED2);
        if (fq == 0) red[t * 2 + jh] = ss;
        __syncthreads();
        const float rstd = rsqrtf((red[t * 2] + red[t * 2 + 1]) * (1.0f / 256.0f) + EPS);
#pragma unroll
        for (int jt = 0; jt < 8; ++jt) { const int j0 = jh * 128 + jt * 16 + 4 * fq; u32x2 w; w.x = pk2(acc[jt].x * rstd, acc[jt].y * rstd); w.y = pk2(acc[jt].z * rstd, acc[jt].w * rstd);
            *(u32x2*)(Y + (size_t)(t0 + t) * DM + j0) = w; }
    }
    __syncthreads();
}

constexpr int OFF_LA = 0, OFF_LB = 65536, OFF_XC = 65536;
template <bool FULL> __device__ __forceinline__ void lru_tile(const Args& a, int l, int tile, LAS unsigned char* lds, int tid, int lane, int wave) {
    const bf16* Z = (const bf16*)(a.ws + WS_HZ); bf16* Y = (bf16*)(a.ws + WS_Y);
    const int t0 = tile * 64, fr = lane & 15, fq = lane >> 4; const int tloc0 = (tile & 127) * 64;
    unsigned char* wl = a.ws + WS_W + (size_t)l * WL_STRIDE;
    if constexpr (FULL) {
#pragma unroll
        for (int it = 0; it < 4; ++it) { const int ch = it * NTHR + tid, t = ch >> 5, c8 = ch & 31;
            const u32x4 lv = *(const u32x4*)(Y + (size_t)(t0 + t) * DM + 768 + c8 * 8), bw = *(const u32x4*)(Y + (size_t)(t0 + t) * DM + 512 + c8 * 8);
            float lf[8], bf[8]; unpack8(lv, lf); unpack8(bw, bf);
            LAS f32x4* pa = (LAS f32x4*)(lds + OFF_LA + (t * 256 + c8 * 8) * 4); LAS f32x4* pb = (LAS f32x4*)(lds + OFF_LB + (t * 256 + c8 * 8) * 4);
            pa[0] = (f32x4){__expf(lf[0]), __expf(lf[1]), __expf(lf[2]), __expf(lf[3])}; pa[1] = (f32x4){__expf(lf[4]), __expf(lf[5]), __expf(lf[6]), __expf(lf[7])};
            pb[0] = (f32x4){bf[0], bf[1], bf[2], bf[3]}; pb[1] = (f32x4){bf[4], bf[5], bf[6], bf[7]}; }
    } else {
#pragma unroll
    for (int it = 0; it < 4; ++it) {
        const int ch = it * NTHR + tid, t = ch >> 5, c8 = ch & 31;
        float xc[8];
        { const f32x4 b0 = *(const f32x4*)(a.in[20] + (size_t)l * 256 + c8 * 8), b1 = *(const f32x4*)(a.in[20] + (size_t)l * 256 + c8 * 8 + 4);
          xc[0] = b0.x; xc[1] = b0.y; xc[2] = b0.z; xc[3] = b0.w; xc[4] = b1.x; xc[5] = b1.y; xc[6] = b1.z; xc[7] = b1.w; }
#pragma unroll
        for (int j = 0; j < 4; ++j) {
            if (tloc0 + t + j - 3 >= 0) {
                const u32x4 v = *(const u32x4*)(Z + (size_t)(t0 + t + j - 3) * IW + 2304 + c8 * 8); float f[8]; unpack8(v, f);
                const f32x4 w0 = *(const f32x4*)(a.in[19] + ((size_t)l * 4 + j) * 256 + c8 * 8), w1 = *(const f32x4*)(a.in[19] + ((size_t)l * 4 + j) * 256 + c8 * 8 + 4);
                xc[0] = fmaf(w0.x, f[0], xc[0]); xc[1] = fmaf(w0.y, f[1], xc[1]); xc[2] = fmaf(w0.z, f[2], xc[2]); xc[3] = fmaf(w0.w, f[3], xc[3]);
                xc[4] = fmaf(w1.x, f[4], xc[4]); xc[5] = fmaf(w1.y, f[5], xc[5]); xc[6] = fmaf(w1.z, f[6], xc[6]); xc[7] = fmaf(w1.w, f[7], xc[7]);
            }
        }
        u32x4 w; w.x = pk2(xc[0], xc[1]); w.y = pk2(xc[2], xc[3]); w.z = pk2(xc[4], xc[5]); w.w = pk2(xc[6], xc[7]);
        *(LAS u32x4*)(lds + OFF_XC + (t * 264 + c8 * 8) * 2) = w;
    }
    __syncthreads();
    {
        const int cb = wave & 3, chh = wave >> 2; const bf16* WA = (const bf16*)(wl + WL_WA); const bf16* WX = (const bf16*)(wl + WL_WX);
        const float* c8t = (const float*)(a.ws + WS_TAB) + (size_t)l * 256;
        f32x4 av[8], bv[8];
#pragma unroll
        for (int et = 0; et < 8; ++et) {
            const int e0 = chh * 128 + et * 16, nb = e0 >> 6, el = e0 & 63;
            f32x4 ra = {0.f, 0.f, 0.f, 0.f}, ia = {0.f, 0.f, 0.f, 0.f};
#pragma unroll
            for (int ks = 0; ks < 2; ++ks) {
                const bf16x8 xv = *(const LAS bf16x8*)(lds + OFF_XC + ((cb * 16 + fr) * 264 + nb * 64 + 32 * ks + 8 * fq) * 2);
                const bf16x8 wa = *(const bf16x8*)(WA + (size_t)nb * 4096 + (el + fr) * 64 + 32 * ks + 8 * fq);
                const bf16x8 wx = *(const bf16x8*)(WX + (size_t)nb * 4096 + (el + fr) * 64 + 32 * ks + 8 * fq);
                MFMA16(wa, xv, ra); MFMA16(wx, xv, ia);
            }
            const int c0 = e0 + 4 * fq;
            const f32x4 ba = *(const f32x4*)(a.in[22] + (size_t)l * 256 + c0), bx = *(const f32x4*)(a.in[24] + (size_t)l * 256 + c0), c8v = *(const f32x4*)(c8t + c0);
            const u32x2 xr = *(const LAS u32x2*)(lds + OFF_XC + ((cb * 16 + fr) * 264 + c0) * 2);
            float lav[4];
            const float xcv[4] = {__uint_as_float(xr.x << 16), __uint_as_float(xr.x & 0xffff0000u), __uint_as_float(xr.y << 16), __uint_as_float(xr.y & 0xffff0000u)};
#pragma unroll
            for (int r = 0; r < 4; ++r) {
                const float rg = sigmoidf_(ra[r] + ba[r]), ig = sigmoidf_(ia[r] + bx[r]);
                const float la = c8v[r] * rg; const float av_ = __expf(la); const float m2 = -expm1f(2.0f * la);
                av[et][r] = av_; bv[et][r] = sqrtf(fmaxf(m2, 0.f)) * ig * xcv[r]; lav[r] = la;
            }
            {
              bf16* yr = Y + (size_t)(t0 + cb * 16 + fr) * DM + c0;
              u32x2 wl_; wl_.x = pk2(lav[0], lav[1]); wl_.y = pk2(lav[2], lav[3]); *(u32x2*)(yr + 768) = wl_;
              u32x2 wb_; wb_.x = pk2(bv[et][0], bv[et][1]); wb_.y = pk2(bv[et][2], bv[et][3]); *(u32x2*)(yr + 512) = wb_; }
            if ((et & 3) == 3) asm volatile("" ::: "memory");
        }
        __syncthreads();
#pragma unroll
        for (int et = 0; et < 8; ++et) { const int c0 = chh * 128 + et * 16 + 4 * fq, t = cb * 16 + fr;
            *(LAS f32x4*)(lds + OFF_LA + (t * 256 + c0) * 4) = av[et]; *(LAS f32x4*)(lds + OFF_LB + (t * 256 + c0) * 4) = bv[et]; }
    }
    }
    __syncthreads();
    float* AE = (float*)(a.ws + WS_LRUC); float* HE = AE + 2 * 128 * 256;
    if (tid < 256) {
        LAS float* A = (LAS float*)(lds + OFF_LA) + tid; LAS float* B = (LAS float*)(lds + OFF_LB) + tid;
        float h = FULL ? HE[(size_t)tile * 256 + tid] : 0.f, P = 1.f;
        for (int tb = 0; tb < 64; tb += 16) {
            float av_[16], bv_[16];
#pragma unroll
            for (int j = 0; j < 16; ++j) { av_[j] = A[(tb + j) * 256]; bv_[j] = B[(tb + j) * 256]; }
#pragma unroll
            for (int j = 0; j < 16; ++j) { h = fmaf(av_[j], h, bv_[j]); if (FULL) bv_[j] = h; else P *= av_[j]; }
            if (FULL) {
#pragma unroll
                for (int j = 0; j < 16; ++j) B[(tb + j) * 256] = bv_[j];
            }
        }
        if (!FULL) { AE[(size_t)tile * 256 + tid] = P; HE[(size_t)tile * 256 + tid] = h; }
    }
    __syncthreads();
    if (FULL) {
#pragma unroll
        for (int it = 0; it < 4; ++it) {
            const int ch = it * NTHR + tid, t = ch >> 5, c8 = ch & 31;
            const LAS f32x4* hp = (const LAS f32x4*)(lds + OFF_LB + (t * 256 + c8 * 8) * 4); const f32x4 h0 = hp[0], h1 = hp[1];
            const u32x4 gv = *(const u32x4*)(Z + (size_t)(t0 + t) * IW + 2560 + c8 * 8); float g[8]; unpack8(gv, g);
            float o[8] = {h0.x * g[0], h0.y * g[1], h0.z * g[2], h0.w * g[3], h1.x * g[4], h1.y * g[5], h1.z * g[6], h1.w * g[7]};
            float ss = 0.f;
#pragma unroll
            for (int i = 0; i < 8; ++i) ss += o[i] * o[i];
#pragma unroll
            for (int s = 1; s < 32; s <<= 1) ss += __shfl_xor(ss, s);
            const float rstd = rsqrtf(ss * (1.0f / 256.0f) + EPS);
            u32x4 w; w.x = pk2(o[0] * rstd, o[1] * rstd); w.y = pk2(o[2] * rstd, o[3] * rstd); w.z = pk2(o[4] * rstd, o[5] * rstd); w.w = pk2(o[6] * rstd, o[7] * rstd);
            *(u32x4*)(Y + (size_t)(t0 + t) * DM + 768 + c8 * 8) = w;
        }
        __syncthreads();
    }
}

constexpr int OFF_QS = 0, OFF_KS = 17408, OFF_VT = 52224, OFF_PT = 87040, OFF_SS = 121856, OFF_RED = 139264;
__device__ __forceinline__ float ret_lg2(int h) { return log2f(1.0f - exp2f(-5.0f - (float)h)); }
typedef short s16x4 __attribute__((ext_vector_type(4)));
__device__ __forceinline__ bf16x8 tr_frag(LAS unsigned char* base, int stride, int k0, int c0, int lane) {
    const int fq = lane >> 4, q = (lane & 15) >> 2, p = lane & 3;
    LAS unsigned char* a0 = base + (k0 + 8 * fq + q) * stride + (c0 + 4 * p) * 2;
    const s16x4 lo = __builtin_amdgcn_ds_read_tr16_b64_v4i16((LAS s16x4*)a0);
    const s16x4 hi = __builtin_amdgcn_ds_read_tr16_b64_v4i16((LAS s16x4*)(a0 + 4 * stride));
    return (bf16x8){lo[0], lo[1], lo[2], lo[3], hi[0], hi[1], hi[2], hi[3]};
}
template <int NR, bool ZETA> __device__ __forceinline__ void ret_load_R(const bf16* Z, int r0, int c0, LAS unsigned char* dst, int tid, float lg2) {
#pragma unroll
    for (int it = 0; it < NR / 32; ++it) { const int ch = it * NTHR + tid, r = ch >> 4, c = ch & 15;
        u32x4 v = *(const u32x4*)(Z + (size_t)(r0 + r) * IW + c0 + c * 8);
        if (ZETA) { const float zs = exp2f((float)(127 - r) * lg2); float f[8]; unpack8(v, f);
            v.x = pk2(f[0] * zs, f[1] * zs); v.y = pk2(f[2] * zs, f[3] * zs); v.z = pk2(f[4] * zs, f[5] * zs); v.w = pk2(f[6] * zs, f[7] * zs); }
        *(LAS u32x4*)(dst + (r * 136 + c * 8) * 2) = v; }
}
template <bool ZETA> __device__ __forceinline__ void ret_load_T(const bf16* Z, int r0, int c0, LAS unsigned char* dst, int tid, float lg2) {
    const int m = tid & 127; const float zs = ZETA ? exp2f((float)(127 - m) * lg2) : 1.0f;
#pragma unroll
    for (int it = 0; it < 4; ++it) { const int dc = (tid >> 7) + 4 * it;
        const u32x4 v = *(const u32x4*)(Z + (size_t)(r0 + m) * IW + c0 + dc * 8); float f[8]; unpack8(v, f);
#pragma unroll
        for (int i = 0; i < 8; i += 2) { const unsigned pr = pk2(f[i] * zs, f[i + 1] * zs);
            *(LAS bf16*)(dst + ((dc * 8 + i) * 136 + m) * 2) = (bf16)(pr & 0xffffu); *(LAS bf16*)(dst + ((dc * 8 + i + 1) * 136 + m) * 2) = (bf16)(pr >> 16); }
    }
}
__device__ __forceinline__ void ret_kv(const Args& a, int unit, LAS unsigned char* lds, int tid, int lane, int wave) {
    const bf16* Z = (const bf16*)(a.ws + WS_HZ);
    const int n = unit & 63, bh = unit >> 6, h = bh & 3, b = bh >> 2, r0 = b * SEQ + n * 128, fr = lane & 15, fq = lane >> 4;
    const float lg2 = ret_lg2(h);
    ret_load_R<128, true>(Z, r0, 768 + h * 128, lds + OFF_KS, tid, lg2);
    ret_load_R<128, false>(Z, r0, 1280 + h * 128, lds + OFF_VT, tid, lg2);
    __syncthreads();
    const int eb = (wave & 3) * 32, dh = (wave >> 2) * 64;
    f32x4 acc[2][4];
#pragma unroll
    for (int i = 0; i < 2; ++i)
#pragma unroll
        for (int j = 0; j < 4; ++j) acc[i][j] = (f32x4){0.f, 0.f, 0.f, 0.f};
#pragma unroll
    for (int ks = 0; ks < 4; ++ks) {
        bf16x8 vf[2], kf[4];
#pragma unroll
        for (int i = 0; i < 2; ++i) vf[i] = tr_frag(lds + OFF_VT, 272, 32 * ks, eb + i * 16, lane);
#pragma unroll
        for (int j = 0; j < 4; ++j) kf[j] = tr_frag(lds + OFF_KS, 272, 32 * ks, dh + j * 16, lane);
#pragma unroll
        for (int i = 0; i < 2; ++i)
#pragma unroll
            for (int j = 0; j < 4; ++j) MFMA16(kf[j], vf[i], acc[i][j]);
        asm volatile("" ::: "memory");
    }
    float* KV = (float*)(a.ws + WS_KV) + (size_t)unit * 16384;
#pragma unroll
    for (int i = 0; i < 2; ++i)
#pragma unroll
        for (int j = 0; j < 4; ++j) *(f32x4*)(KV + (size_t)(eb + i * 16 + fr) * 128 + dh + j * 16 + 4 * fq) = acc[i][j];
    __syncthreads();
}
__device__ __forceinline__ void ret_out(const Args& a, int tile, LAS unsigned char* lds, int tid, int lane, int wave) {
    const bf16* Z = (const bf16*)(a.ws + WS_HZ); bf16* Y = (bf16*)(a.ws + WS_Y); const bf16* PB = (const bf16*)(a.ws + WS_PB);
    const int b = tile >> 7, n = (tile & 127) >> 1, half = tile & 1, t0 = tile * 64, k0 = b * SEQ + n * 128, fr = lane & 15, fq = lane >> 4;
    const int cb = wave & 3, hv = wave >> 2;
    const int cg = half * 64 + cb * 16 + fr;
    const int nit = half ? 4 : 2;
    LAS float* red = (LAS float*)(lds + OFF_RED);
    const int lr = tid >> 4, lc = tid & 15;
    u32x4 rq[2], rk[4], rv[4], rp[4];
#define RET_ISSUE(h_) do { \
        _Pragma("unroll") for (int it = 0; it < 2; ++it) rq[it] = *(const u32x4*)(Z + (size_t)(t0 + it * 32 + lr) * IW + 256 + (h_) * 128 + lc * 8); \
        _Pragma("unroll") for (int it = 0; it < 4; ++it) if (it < nit) { rk[it] = *(const u32x4*)(Z + (size_t)(k0 + it * 32 + lr) * IW + 768 + (h_) * 128 + lc * 8); \
                                                                          rv[it] = *(const u32x4*)(Z + (size_t)(k0 + it * 32 + lr) * IW + 1280 + (h_) * 128 + lc * 8); } \
        { const bf16* P_ = PB + (size_t)(((b * 4 + (h_)) * 64) + n) * 16384; \
          _Pragma("unroll") for (int it = 0; it < 4; ++it) rp[it] = *(const u32x4*)(P_ + (size_t)(it * 32 + lr) * 128 + lc * 8); } } while (0)
    RET_ISSUE(0);
    float ss512 = 0.f;
#pragma unroll 1
    for (int h = 0; h < 4; ++h) {
        const float lg2 = ret_lg2(h);
#pragma unroll
        for (int it = 0; it < 2; ++it) *(LAS u32x4*)(lds + OFF_QS + ((it * 32 + lr) * 136 + lc * 8) * 2) = rq[it];
#pragma unroll
        for (int it = 0; it < 4; ++it) if (it < nit) { *(LAS u32x4*)(lds + OFF_KS + ((it * 32 + lr) * 136 + lc * 8) * 2) = rk[it]; *(LAS u32x4*)(lds + OFF_VT + ((it * 32 + lr) * 136 + lc * 8) * 2) = rv[it]; }
#pragma unroll
        for (int it = 0; it < 4; ++it) *(LAS u32x4*)(lds + OFF_PT + ((it * 32 + lr) * 136 + lc * 8) * 2) = rp[it];
        __syncthreads();
        if (h < 3) RET_ISSUE(h + 1);
        u32x2 gr[4];
#pragma unroll
        for (int et = 0; et < 4; ++et) gr[et] = *(const u32x2*)(Z + (size_t)(t0 + cb * 16 + fr) * IW + 1792 + h * 128 + hv * 64 + et * 16 + 4 * fq);
        if (hv == 0 || half) {
            f32x4 sc[4];
#pragma unroll
            for (int mt = 0; mt < 4; ++mt) sc[mt] = (f32x4){0.f, 0.f, 0.f, 0.f};
#pragma unroll
            for (int ks = 0; ks < 4; ++ks) {
                const bf16x8 qf = *(const LAS bf16x8*)(lds + OFF_QS + ((cb * 16 + fr) * 136 + 32 * ks + 8 * fq) * 2);
#pragma unroll
                for (int mt = 0; mt < 4; ++mt) { const bf16x8 kf = *(const LAS bf16x8*)(lds + OFF_KS + ((hv * 64 + mt * 16 + fr) * 136 + 32 * ks + 8 * fq) * 2); MFMA16(kf, qf, sc[mt]); }
            }
#pragma unroll
            for (int mt = 0; mt < 4; ++mt) { const int m0 = hv * 64 + mt * 16 + 4 * fq; float v[4];
#pragma unroll
                for (int r = 0; r < 4; ++r) { const int dm = cg - (m0 + r); v[r] = (dm >= 0) ? sc[mt][r] * exp2f((float)dm * lg2) : 0.f; }
                u32x2 w; w.x = pk2(v[0], v[1]); w.y = pk2(v[2], v[3]);
                *(LAS u32x2*)(lds + OFF_SS + ((cb * 16 + fr) * 136 + m0) * 2) = w; }
        }
        __syncthreads();
        f32x4 oi[4], oc[4];
#pragma unroll
        for (int et = 0; et < 4; ++et) { oi[et] = (f32x4){0.f, 0.f, 0.f, 0.f}; oc[et] = (f32x4){0.f, 0.f, 0.f, 0.f}; }
#pragma unroll
        for (int ks = 0; ks < 4; ++ks) {
            const bf16x8 qf = *(const LAS bf16x8*)(lds + OFF_QS + ((cb * 16 + fr) * 136 + 32 * ks + 8 * fq) * 2);
#pragma unroll
            for (int et = 0; et < 4; ++et) { const bf16x8 pf = *(const LAS bf16x8*)(lds + OFF_PT + ((hv * 64 + et * 16 + fr) * 136 + 32 * ks + 8 * fq) * 2); MFMA16(pf, qf, oc[et]); }
            if (ks < nit) {
                const bf16x8 sf = *(const LAS bf16x8*)(lds + OFF_SS + ((cb * 16 + fr) * 136 + 32 * ks + 8 * fq) * 2);
#pragma unroll
                for (int et = 0; et < 4; ++et) { const bf16x8 vf = tr_frag(lds + OFF_VT, 272, 32 * ks, hv * 64 + et * 16, lane); MFMA16(vf, sf, oi[et]); }
            }
        }
        const float xi = exp2f((float)(cg + 1) * lg2);
        float ss = 0.f;
#pragma unroll
        for (int et = 0; et < 4; ++et) { oi[et] = oi[et] + oc[et] * xi; ss += (oi[et].x * oi[et].x + oi[et].y * oi[et].y) + (oi[et].z * oi[et].z + oi[et].w * oi[et].w); }
        ss += __shfl_xor(ss, 16); ss += __shfl_xor(ss, 32);
        if (fq == 0) red[(h * 64 + cb * 16 + fr) * 2 + hv] = ss;
        __syncthreads();
        const float rstd = rsqrtf((red[(h * 64 + cb * 16 + fr) * 2] + red[(h * 64 + cb * 16 + fr) * 2 + 1]) * (1.0f / 128.0f) + EPS);
#pragma unroll
        for (int et = 0; et < 4; ++et) {
            f32x4 o;
            o.x = oi[et].x * rstd * __uint_as_float(gr[et].x << 16); o.y = oi[et].y * rstd * __uint_as_float(gr[et].x & 0xffff0000u);
            o.z = oi[et].z * rstd * __uint_as_float(gr[et].y << 16); o.w = oi[et].w * rstd * __uint_as_float(gr[et].y & 0xffff0000u);
            ss512 += (o.x * o.x + o.y * o.y) + (o.z * o.z + o.w * o.w);
            u32x2 w; w.x = pk2(o.x, o.y); w.y = pk2(o.z, o.w);
            *(u32x2*)(Y + (size_t)(t0 + cb * 16 + fr) * DM + 256 + h * 128 + hv * 64 + et * 16 + 4 * fq) = w;
        }
    }
#undef RET_ISSUE
    ss512 += __shfl_xor(ss512, 16); ss512 += __shfl_xor(ss512, 32);
    LAS float* red5 = red + 512;
    if (fq == 0) red5[(cb * 16 + fr) * 2 + hv] = ss512;
    __syncthreads();
    const float rstd = rsqrtf((red5[(cb * 16 + fr) * 2] + red5[(cb * 16 + fr) * 2 + 1]) * (1.0f / 512.0f) + EPS);
#pragma unroll 1
    for (int h = 0; h < 4; ++h)
#pragma unroll
        for (int et = 0; et < 4; ++et) { u32x2* yp = (u32x2*)(Y + (size_t)(t0 + cb * 16 + fr) * DM + 256 + h * 128 + hv * 64 + et * 16 + 4 * fq); const u32x2 r = *yp;
            u32x2 w; w.x = pk2(__uint_as_float(r.x << 16) * rstd, __uint_as_float(r.x & 0xffff0000u) * rstd); w.y = pk2(__uint_as_float(r.y << 16) * rstd, __uint_as_float(r.y & 0xffff0000u) * rstd);
            *yp = w; }
    __syncthreads();
}

__device__ __forceinline__ void m2_scans(const Args& a, int l, int tid, int G) {
    const int gt = blockIdx.x * NTHR + tid, NGT = G * NTHR;
    const int rt = NGT - 1 - gt, NRT = NGT - 2560;
    if (rt >= 2560)
    for (int r = gt; r < 8 * 8192; r += NRT) {
        const int bh = r >> 13, ed = (r & 8191) * 2, h = bh & 3;
        const float gC = exp2f(128.0f * ret_lg2(h));
        const float* p = (const float*)(a.ws + WS_KV) + (size_t)bh * 64 * 16384 + ed; bf16* pb = (bf16*)(a.ws + WS_PB) + (size_t)bh * 64 * 16384 + ed;
        float S0 = 0.f, S1 = 0.f;
        for (int nb = 0; nb < 64; nb += 32) {
            f32x2 v[32];
#pragma unroll
            for (int j = 0; j < 32; ++j) v[j] = *(const f32x2*)(p + (size_t)(nb + j) * 16384);
#pragma unroll
            for (int j = 0; j < 32; ++j) { *(unsigned*)(pb + (size_t)(nb + j) * 16384) = pk2(S0, S1); S0 = fmaf(gC, S0, v[j].x); S1 = fmaf(gC, S1, v[j].y); }
        }
    }
    if (rt < 2048) {
        const int p = rt & 63, g = (rt >> 6) & 15, b = rt >> 10;
        const float* tab = (const float*)(a.ws + WS_W + (size_t)l * WL_STRIDE + WL_S5T) + (size_t)g * 36 * 64;
        const float cr = tab[128 + p], ci = tab[192 + p];
        float* E = (float*)(a.ws + WS_S5E);
        float sre = 0.f, sim = 0.f;
        for (int nb = 0; nb < 128; nb += 32) {
            float er[32], ei[32];
#pragma unroll
            for (int j = 0; j < 32; ++j) { const size_t o = ((size_t)((b * 128 + nb + j) * 16 + g) * 2) * 64 + p; er[j] = E[o]; ei[j] = E[o + 64]; }
#pragma unroll
            for (int j = 0; j < 32; ++j) { const size_t o = ((size_t)((b * 128 + nb + j) * 16 + g) * 2) * 64 + p; E[o] = sre; E[o + 64] = sim;
                const float nre = cr * sre - ci * sim + er[j], nim = cr * sim + ci * sre + ei[j]; sre = nre; sim = nim; }
        }
    } else if (rt < 2048 + 512) {
        const int q = rt - 2048, ch = q & 255, b = q >> 8;
        float* AE = (float*)(a.ws + WS_LRUC); float* HE = AE + 2 * 128 * 256;
        float hcar = 0.f;
        for (int nb = 0; nb < 128; nb += 32) {
            float av[32], hv[32];
#pragma unroll
            for (int j = 0; j < 32; ++j) { const size_t o = (size_t)(b * 128 + nb + j) * 256 + ch; av[j] = AE[o]; hv[j] = HE[o]; }
#pragma unroll
            for (int j = 0; j < 32; ++j) { const size_t o = (size_t)(b * 128 + nb + j) * 256 + ch; HE[o] = hcar; hcar = fmaf(av[j], hcar, hv[j]); }
        }
    }
}

__global__ void __launch_bounds__(NTHR, 2) fwd_kernel(Args a) {
    extern __shared__ __attribute__((aligned(16))) unsigned char lds_raw[];
    LAS unsigned char* lds = (LAS unsigned char*)lds_raw;
    cg::grid_group grid = cg::this_grid();
    const int G = gridDim.x;
#define PH_IDS int tid = threadIdx.x; asm volatile("" : "+v"(tid)); const int lane = tid & 63, wave = __builtin_amdgcn_readfirstlane(tid >> 6); (void)lane; (void)wave;
    bf16* XB = (bf16*)(a.ws + WS_XB); bf16* HZ = (bf16*)(a.ws + WS_HZ); bf16* Y = (bf16*)(a.ws + WS_Y); float* SSQ = (float*)(a.ws + WS_SSQ);
    const float* RC = (const float*)(a.ws + WS_ROPE); const float* RS = RC + SEQ * 64;

    volatile LAS unsigned* MISC = (volatile LAS unsigned*)(lds + MISC_OFF);
    if (threadIdx.x < 16) MISC[threadIdx.x] = 0u;
    __syncthreads();
    const XcdBarrier bar = xcd_barrier_post((unsigned*)(a.ws + WS_CTL) + CW_BAR, MISC + 8);
    { PH_IDS p0_prologue(a, lds, tid, lane, wave, G); }
    grid.sync();
#define GRID_BAR() xcd_barrier(bar)

    for (int l = 0; l < NL; ++l) {
        unsigned char* wl = a.ws + WS_W + (size_t)l * WL_STRIDE;
#pragma unroll 1
        for (int f = 0; f < 2; ++f) {
            if (f == 1) {
                { pg8::Gemm g{XB, (const bf16*)(wl + WL_WIN), NTOK, IW, DM}; pg8::StaticOrder S; S.init(NTOK, IW, G, (int)blockIdx.x);
                  EpiWin E{HZ, SSQ, RC, RS, lds + OFF_SSQL};
                  pg8::gemm_phase<EpiWin, pg8::StaticOrder, true, true>(lds, g, S, E); }
                if (G == 256 && blockIdx.x >= 192) tail_convert(a, l + 1, 128 + (int)blockIdx.x - 192, lds);
                GRID_BAR();
                for (int it = blockIdx.x; it < 768; it += G) { PH_IDS
                    const int bx = it & 255, s = it >> 8, xq = bx & 7, jq = bx >> 3;
                    if (it < 256) { const int tile = (G == 256) ? xq * 32 + jq : it; s5_m1(a, l, tile, lds, tid, lane, wave); lru_tile<false>(a, l, tile, lds, tid, lane, wave); }
                    else { const int q = jq + 32 * (s - 1); const int unit = (G == 256) ? (((xq >> 2) * 4 + (q & 3)) * 64 + (xq & 3) * 16 + (q >> 2)) : it - 256; ret_kv(a, unit, lds, tid, lane, wave); }
                }
                GRID_BAR();
                { PH_IDS m2_scans(a, l, tid, G); }
                GRID_BAR();
                for (int it0 = blockIdx.x; it0 < 256; it0 += G) {
                    const int it = (G == 256) ? (it0 & 7) * 32 + (it0 >> 3) : it0;
                    { PH_IDS lru_tile<true>(a, l, it, lds, tid, lane, wave); }
                    { PH_IDS ret_out(a, it, lds, tid, lane, wave); }
                    { PH_IDS s5_m3(a, l, it, lds, tid, lane, wave); }
                }
                GRID_BAR();
                { pg8::Gemm g{Y, (const bf16*)(wl + WL_WOUT), NTOK, DM, DM}; pg8::StaticOrder S; S.init(NTOK, DM, G, (int)blockIdx.x);
                  EpiRes E{XB, SSQ, 1.0f, 1.0f};
                  pg8::gemm_phase<EpiRes, pg8::StaticOrder, true, true>(lds, g, S, E); }
                GRID_BAR();
            }
            { pg8::Gemm g{XB, (const bf16*)(wl + (f ? WL_GU2 : WL_GU1)), NTOK, 2 * FF, DM}; pg8::StaticOrder S; S.init(NTOK, 2 * FF, G, (int)blockIdx.x);
              EpiGU E{HZ, SSQ, lds + OFF_SSQL};
              pg8::gemm_phase<EpiGU, pg8::StaticOrder, true, true>(lds, g, S, E); }
            if (G == 256 && blockIdx.x >= 128) tail_convert(a, l + 1, f * 192 + (int)blockIdx.x - 128, lds);
            GRID_BAR();
            { pg8::Gemm g{HZ, (const bf16*)(wl + (f ? WL_D2 : WL_D1)), NTOK, DM, FF}; pg8::StaticOrder S; S.init(NTOK, DM, G, (int)blockIdx.x);
              EpiRes E{XB, SSQ, 0.5f, 2.0f};
              pg8::gemm_phase<EpiRes, pg8::StaticOrder, true, true>(lds, g, S, E); }
            GRID_BAR();
        }
    }
    { PH_IDS
        const int gw = blockIdx.x * NWAVE + wave, NGW = G * NWAVE; const float* fn = a.in[32];
        for (int m = gw; m < NTOK; m += NGW) {
            const u32x2* xr = (const u32x2*)(XB + (size_t)m * DM) + lane; f32x4* orow = (f32x4*)(a.out + (size_t)m * DM) + lane; f32x4 v[4]; float s = 0.f;
#pragma unroll
            for (int j = 0; j < 4; ++j) { const u32x2 r = xr[64 * j]; v[j] = (f32x4){__uint_as_float(r.x << 16), __uint_as_float(r.x & 0xffff0000u), __uint_as_float(r.y << 16), __uint_as_float(r.y & 0xffff0000u)};
                s += (v[j].x * v[j].x + v[j].y * v[j].y) + (v[j].z * v[j].z + v[j].w * v[j].w); }
            const float rstd = rsqrtf(wave_sum(s) * (1.0f / DM) + EPS);
#pragma unroll
            for (int j = 0; j < 4; ++j) { const f32x4 gn = *((const f32x4*)fn + lane + 64 * j); orow[64 * j] = v[j] * rstd * gn; }
        }
    }
}

extern "C" void kernel_launch(void* const* d_in, const int* in_sizes, int n_in, void* d_out, int out_size, void* d_ws, size_t ws_size, hipStream_t stream) {
    static int grid = 0;
    if (grid == 0) {
        if (n_in != 33 || in_sizes[0] != NTOK * DM || out_size != NTOK * DM || ws_size < WS_END) { fprintf(stderr, "kernel_launch: unexpected shapes (n_in %d, in0 %d, out %d, ws %zu < %zu)\n", n_in, n_in > 0 ? in_sizes[0] : -1, out_size, ws_size, (size_t)WS_END); grid = -1; return; }
        int dev = 0, cus = 0, per_cu = 0;
        hipGetDevice(&dev); hipDeviceGetAttribute(&cus, hipDeviceAttributeMultiprocessorCount, dev);
        if (hipFuncSetAttribute((const void*)fwd_kernel, hipFuncAttributeMaxDynamicSharedMemorySize, LDS_BYTES) != hipSuccess) { fprintf(stderr, "kernel_launch: hipFuncSetAttribute failed\n"); grid = -1; return; }
        if (hipOccupancyMaxActiveBlocksPerMultiprocessor(&per_cu, (const void*)fwd_kernel, NTHR, LDS_BYTES) != hipSuccess || per_cu < 1) { fprintf(stderr, "kernel_launch: occupancy query says %d\n", per_cu); per_cu = 1; }
        (void)hipGetLastError();
        grid = cus * 1;
    }
    if (grid < 0) return;
    Args a{};
    for (int i = 0; i < 33; ++i) a.in[i] = (const float*)d_in[i];
    a.out = (float*)d_out; a.ws = (unsigned char*)d_ws;
    if (hipMemsetAsync((char*)d_ws + WS_CTL, 0, 65536, stream) != hipSuccess) { fprintf(stderr, "kernel_launch: memset failed\n"); return; }
    void* args[] = {&a};
    hipError_t e = hipLaunchCooperativeKernel((const void*)fwd_kernel, dim3(grid), dim3(NTHR), args, LDS_BYTES, stream);
    if (e != hipSuccess) fprintf(stderr, "kernel_launch: cooperative launch failed: %s (grid %d)\n", hipGetErrorString(e), grid);
}
```
